# Optimizing an MI355X kernel written in HIP

```python
import jax, jax.numpy as jnp
from jax import lax
import numpy as np

D_MODEL = 1024
BATCH = 8
SEQ = 2048
DEPTH = 1
DEC_BATCH = 128
DEC_SEQ = 1
PAST_LEN = 16384
PAGE_SIZE = 128

MIX_WIDTH = 2 * D_MODEL
CONV_CH = MIX_WIDTH // 2
CONV_GROUPS = 16
SHORT_CONV_W = 3
SSM_CH = MIX_WIDTH - CONV_CH
SSM_HEAD_DIM = 64
SSM_HEADS = SSM_CH // SSM_HEAD_DIM
SSM_GROUPS = 2
SSM_STATE = 128
SSM_CONV_W = 4
SSM_CHUNK = 128
XBC_CH = SSM_CH + 2 * SSM_GROUPS * SSM_STATE
IN_COLS = 3 * CONV_CH + SSM_CH + XBC_CH + SSM_HEADS
D_FF = 4 * D_MODEL
ALPHA = (2 * DEPTH) ** 0.25
BETA = (8 * DEPTH) ** -0.25
LN_EPS = 1e-5
RMS_EPS = 1e-5

kernel_name = 'hymba_style_shortconv_mamba2_deepnorm_adaln_step'


def layer_norm(x, g, b):
    xf = x.astype(jnp.float32)
    mu = jnp.mean(xf, axis=-1, keepdims=True)
    var = jnp.mean(jnp.square(xf - mu), axis=-1, keepdims=True)
    y = (xf - mu) * lax.rsqrt(var + LN_EPS) * g.astype(jnp.float32) + b.astype(jnp.float32)
    return y.astype(x.dtype)


def group_rms_norm(x, w, n_groups):
    shape = x.shape
    xf = x.astype(jnp.float32).reshape(*shape[:-1], n_groups, shape[-1] // n_groups)
    xf = xf * lax.rsqrt(jnp.mean(jnp.square(xf), axis=-1, keepdims=True) + RMS_EPS)
    return (xf.reshape(shape) * w.astype(jnp.float32)).astype(x.dtype)


def causal_dwconv(inp, buf, w):
    k_w = w.shape[0]
    l_ = inp.shape[1]
    full = jnp.concatenate([buf.astype(inp.dtype), inp], axis=1)
    out = sum(full[:, k:k + l_] * w[k] for k in range(k_w))
    return out, full[:, l_:]


def ssd_chunked(xh, dt, a, bm, cm, s0):
    b_, l_, h_, p_ = xh.shape
    g_, n_ = bm.shape[2], bm.shape[3]
    e_ = h_ // g_
    cl = min(SSM_CHUNK, l_)
    nc = -(-l_ // cl)
    pad = nc * cl - l_
    padf = lambda t: jnp.pad(t, [(0, 0), (0, pad)] + [(0, 0)] * (t.ndim - 2))
    xdt = padf(xh.astype(jnp.float32) * dt[..., None]).reshape(b_, nc, cl, g_, e_, p_)
    dta = padf(dt * a).reshape(b_, nc, cl, g_, e_).transpose(0, 1, 3, 4, 2)
    bm = padf(bm.astype(jnp.float32)).reshape(b_, nc, cl, g_, n_)
    cm = padf(cm.astype(jnp.float32)).reshape(b_, nc, cl, g_, n_)
    acs = jnp.cumsum(dta, axis=-1)
    causal = jnp.tril(jnp.ones((cl, cl), dtype=bool))
    seg = acs[..., :, None] - acs[..., None, :]
    lmat = jnp.exp(jnp.where(causal, seg, -jnp.inf))
    cb = jnp.einsum('bcsgn,bctgn->bcgst', cm, bm)
    y_diag = jnp.einsum('bcgest,bctgep->bcsgep', cb[:, :, :, None] * lmat, xdt)
    decay_out = jnp.exp(acs[..., -1:] - acs)
    chunk_states = jnp.einsum('bcsgn,bcsgep->bcgepn', bm, xdt * decay_out.transpose(0, 1, 4, 2, 3)[..., None])
    chunk_decay = jnp.exp(acs[..., -1])

    def step(carry, inp):
        st, dec = inp
        return carry * dec[..., None, None] + st, carry

    s0g = s0.astype(jnp.float32).reshape(b_, g_, e_, p_, n_)
    s_final, s_prev = lax.scan(step, s0g, (jnp.moveaxis(chunk_states, 1, 0), jnp.moveaxis(chunk_decay, 1, 0)))
    s_prev = jnp.moveaxis(s_prev, 0, 1)
    c_dec = cm[:, :, :, :, None, :] * jnp.exp(acs).transpose(0, 1, 4, 2, 3)[..., None]
    y_off = jnp.einsum('bcsgen,bcgepn->bcsgep', c_dec, s_prev)
    y = (y_diag + y_off).reshape(b_, nc * cl, h_, p_)[:, :l_]
    return y, s_final.reshape(b_, h_, p_, n_)


def mixer(u, conv_buf, ssm_conv_buf, ssm_state, w_in, conv_w, conv_norm_w, ssm_conv_w, ssm_conv_b,
          dt_bias, a_log, d_skip, ssm_norm_w, w_out):
    b_, l_ = u.shape[0], u.shape[1]
    proj = jnp.einsum('bld,dk->blk', u, w_in)
    cuts = [CONV_CH, 2 * CONV_CH, 3 * CONV_CH, 3 * CONV_CH + SSM_CH, 3 * CONV_CH + SSM_CH + XBC_CH]
    gb, gc, hv, z, xbc, dt_raw = jnp.split(proj, cuts, axis=-1)
    cv, new_conv_buf = causal_dwconv(gc * hv, conv_buf, conv_w)
    y_conv = group_rms_norm(gb * cv, conv_norm_w, CONV_GROUPS)
    xbc_c, new_ssm_conv_buf = causal_dwconv(xbc, ssm_conv_buf, ssm_conv_w)
    xbc_c = jax.nn.silu(xbc_c + ssm_conv_b)
    xs, bm, cm = jnp.split(xbc_c, [SSM_CH, SSM_CH + SSM_GROUPS * SSM_STATE], axis=-1)
    xh = xs.reshape(b_, l_, SSM_HEADS, SSM_HEAD_DIM)
    bm = bm.reshape(b_, l_, SSM_GROUPS, SSM_STATE)
    cm = cm.reshape(b_, l_, SSM_GROUPS, SSM_STATE)
    dt = jax.nn.softplus(dt_raw.astype(jnp.float32) + dt_bias.astype(jnp.float32))
    a = -jnp.exp(a_log.astype(jnp.float32))
    y, new_state = ssd_chunked(xh, dt, a, bm, cm, ssm_state)
    y = y + xh.astype(jnp.float32) * d_skip.astype(jnp.float32)[:, None]
    y = y.reshape(b_, l_, SSM_CH) * jax.nn.silu(z.astype(jnp.float32))
    y_ssm = group_rms_norm(y, ssm_norm_w, SSM_GROUPS).astype(u.dtype)
    out = jnp.einsum('blk,kd->bld', jnp.concatenate([y_conv, y_ssm], axis=-1), w_out)
    return out, new_conv_buf, new_ssm_conv_buf, new_state.astype(ssm_state.dtype)


def decoder_layer(x, c, conv_buf, ssm_conv_buf, ssm_state, w_ada, b_ada, w_in, conv_w, conv_norm_w,
                  ssm_conv_w, ssm_conv_b, dt_bias, a_log, d_skip, ssm_norm_w, w_out,
                  ln1_g, ln1_b, w_up, w_down, ln2_g, ln2_b):
    mod = (c @ w_ada + b_ada)[:, None, :]
    sh1, sc1, g1, sh2, sc2, g2 = jnp.split(mod, 6, axis=-1)
    u = x * (1 + sc1) + sh1
    m, new_conv, new_ssm_conv, new_ssm = mixer(u, conv_buf, ssm_conv_buf, ssm_state, w_in, conv_w, conv_norm_w,
                                               ssm_conv_w, ssm_conv_b, dt_bias, a_log, d_skip, ssm_norm_w, w_out)
    x = layer_norm(ALPHA * x + (1 + g1) * m, ln1_g, ln1_b)
    v = x * (1 + sc2) + sh2
    hid = jnp.square(jax.nn.relu(jnp.einsum('bld,df->blf', v, w_up)))
    x = layer_norm(ALPHA * x + (1 + g2) * jnp.einsum('blf,fd->bld', hid, w_down), ln2_g, ln2_b)
    return x, new_conv, new_ssm_conv, new_ssm


def setup_inputs(seed: int = 0) -> dict:
    key = jax.random.key(seed)
    ks = jax.random.split(key, 32)
    f32 = jnp.float32
    nrm = lambda k, shape, s: jax.random.normal(k, shape, f32) * s
    dt0 = jnp.exp(jax.random.uniform(ks[20], (DEPTH, SSM_HEADS), f32, np.log(1e-3), np.log(1e-1)))
    return {
        'x_prompt': nrm(ks[0], (BATCH, SEQ, D_MODEL), 1.0),
        'x_sample': nrm(ks[1], (DEC_BATCH, DEC_SEQ, D_MODEL), 1.0),
        'state_conv': nrm(ks[2], (DEPTH, DEC_BATCH, SHORT_CONV_W - 1, CONV_CH), 1.0),
        'state_ssm_conv': nrm(ks[3], (DEPTH, DEC_BATCH, SSM_CONV_W - 1, XBC_CH), 1.0),
        'state_ssm': nrm(ks[4], (DEPTH, DEC_BATCH, SSM_HEADS, SSM_HEAD_DIM, SSM_STATE), 0.1),
        'c_prompt': nrm(ks[5], (BATCH, D_MODEL), 1.0),
        'c_sample': nrm(ks[6], (DEC_BATCH, D_MODEL), 1.0),
        'w_ada': nrm(ks[7], (DEPTH, D_MODEL, 6 * D_MODEL), 0.1 * D_MODEL ** -0.5),
        'b_ada': nrm(ks[8], (DEPTH, 6 * D_MODEL), 0.01),
        'w_in': nrm(ks[9], (DEPTH, D_MODEL, IN_COLS), D_MODEL ** -0.5),
        'conv_w': nrm(ks[10], (DEPTH, SHORT_CONV_W, CONV_CH), SHORT_CONV_W ** -0.5),
        'conv_norm_w': 1.0 + nrm(ks[11], (DEPTH, CONV_CH), 0.02),
        'ssm_conv_w': nrm(ks[12], (DEPTH, SSM_CONV_W, XBC_CH), SSM_CONV_W ** -0.5),
        'ssm_conv_b': nrm(ks[13], (DEPTH, XBC_CH), 0.01),
        'dt_bias': dt0 + jnp.log(-jnp.expm1(-dt0)),
        'a_log': jnp.log(jax.random.uniform(ks[14], (DEPTH, SSM_HEADS), f32, 1.0, 16.0)),
        'd_skip': 1.0 + nrm(ks[15], (DEPTH, SSM_HEADS), 0.02),
        'ssm_norm_w': 1.0 + nrm(ks[16], (DEPTH, SSM_CH), 0.02),
        'w_out': nrm(ks[17], (DEPTH, MIX_WIDTH, D_MODEL), BETA * MIX_WIDTH ** -0.5),
        'ln1_g': 1.0 + nrm(ks[18], (DEPTH, D_MODEL), 0.02),
        'ln1_b': nrm(ks[19], (DEPTH, D_MODEL), 0.01),
        'w_up': nrm(ks[21], (DEPTH, D_MODEL, D_FF), D_MODEL ** -0.5),
        'w_down': nrm(ks[22], (DEPTH, D_FF, D_MODEL), BETA * D_FF ** -0.5),
        'ln2_g': 1.0 + nrm(ks[23], (DEPTH, D_MODEL), 0.02),
        'ln2_b': nrm(ks[24], (DEPTH, D_MODEL), 0.01),
    }


def reference(x_prompt, x_sample, state_conv, state_ssm_conv, state_ssm, c_prompt, c_sample,
              w_ada, b_ada, w_in, conv_w, conv_norm_w, ssm_conv_w, ssm_conv_b, dt_bias, a_log, d_skip,
              ssm_norm_w, w_out, ln1_g, ln1_b, w_up, w_down, ln2_g, ln2_b):
    bp = x_prompt.shape[0]
    zero_conv = jnp.zeros((bp, SHORT_CONV_W - 1, CONV_CH), x_prompt.dtype)
    zero_ssm_conv = jnp.zeros((bp, SSM_CONV_W - 1, XBC_CH), x_prompt.dtype)
    zero_ssm = jnp.zeros((bp, SSM_HEADS, SSM_HEAD_DIM, SSM_STATE), state_ssm.dtype)
    hp, hs = x_prompt, x_sample
    p_conv, p_sconv, p_ssm, s_conv, s_sconv, s_ssm = [], [], [], [], [], []
    for i in range(DEPTH):
        lw = (w_ada[i], b_ada[i], w_in[i], conv_w[i], conv_norm_w[i], ssm_conv_w[i], ssm_conv_b[i],
              dt_bias[i], a_log[i], d_skip[i], ssm_norm_w[i], w_out[i], ln1_g[i], ln1_b[i],
              w_up[i], w_down[i], ln2_g[i], ln2_b[i])
        hp, pc, psc, pss = decoder_layer(hp, c_prompt, zero_conv, zero_ssm_conv, zero_ssm, *lw)
        hs, sc, ssc, sss = decoder_layer(hs, c_sample, state_conv[i], state_ssm_conv[i], state_ssm[i], *lw)
        p_conv.append(pc); p_sconv.append(psc); p_ssm.append(pss)
        s_conv.append(sc); s_sconv.append(ssc); s_ssm.append(sss)
    return (hp, hs, jnp.stack(p_conv), jnp.stack(p_sconv), jnp.stack(p_ssm),
            jnp.stack(s_conv), jnp.stack(s_sconv), jnp.stack(s_ssm))
```

```cpp
#include <hip/hip_runtime.h>
#include <hip/hip_cooperative_groups.h>
#include <cstdio>
#include <cstdint>
namespace cg = cooperative_groups;
namespace pg8 {
#define PG8_LAS __attribute__((address_space(3)))
typedef unsigned short bf16_t;
typedef short bf16x8 __attribute__((ext_vector_type(8)));
typedef float f32x4 __attribute__((ext_vector_type(4)));
typedef unsigned u32x4 __attribute__((ext_vector_type(4)));
constexpr int BM = 256, BK = 64, HALF = 128, HTB = HALF * BK * 2  , STAGE_BYTES = 8 * HTB, NXCD = 8, WGM = 8;

__host__ __device__ __forceinline__ int lds_byte(int r, int c) { const int st = (r >> 4) * 2 + (c >> 5), rr = r & 15, cc = c & 31, ob = rr * 64 + cc * 2; return st * 1024 + (ob ^ (((ob >> 9) & 1) << 5)); }
__host__ __device__ __forceinline__ void stage_rc(int b, int& R, int& C) { const int st = b / 1024, sb = b % 1024, swz = sb ^ (((sb >> 9) & 1) << 5); R = (st >> 1) * 16 + swz / 64; C = (st & 1) * 32 + (swz % 64) / 2; }
__host__ __device__ __forceinline__ int perm32(int rho) { const int n = rho >> 4, i = rho & 15; return 8 * (i >> 2) + 4 * n + (i & 3); }

struct Unit { int pm, pn; };
struct Gemm { const bf16_t* A; const bf16_t* Bt; int M, N, K; };

struct StaticOrder {
    int nM, nN, nwg, G, c;
    __host__ __device__ void init(int M, int N, int G_, int c_) { nM = M / BM; nN = N / BM; nwg = nM * nN; G = G_; c = c_; }
    __host__ __device__ bool next(int i, Unit& u) const {
        const long L = (long)i * G + c; if (L >= nwg) return false;
        int wgid = (int)L; { const int q = nwg / NXCD, r = nwg % NXCD, xcd = wgid % NXCD, off = wgid / NXCD; wgid = (xcd < r ? xcd * (q + 1) : r * (q + 1) + (xcd - r) * q) + off; }
        const int nig = WGM * nN, gid = wgid / nig, fm = gid * WGM, gsz = (nM - fm) < WGM ? (nM - fm) : WGM;
        u.pm = fm + ((wgid % nig) % gsz); u.pn = (wgid % nig) / gsz; return true;
    }
    __device__ __forceinline__ void a_ready(const Unit&) const {}
    __device__ __forceinline__ void done(const Unit&) const {}
};

__device__ __forceinline__ unsigned cvt_pk_bf16(float lo, float hi) { unsigned r; asm volatile("v_cvt_pk_bf16_f32 %0, %1, %2" : "=v"(r) : "v"(lo), "v"(hi)); return r; }
typedef float f32x2 __attribute__((ext_vector_type(2)));
typedef unsigned u32x2 __attribute__((ext_vector_type(2)));
struct EpiProj {
    static constexpr bool PERM = true, AFTER_DRAIN = false;
    bf16_t *gb, *gc, *hv, *z, *xbc;
    __device__ __forceinline__ void operator()(const f32x4 (&acc)[2][2][4][2], const Unit& u, int wr, int wc, int fr, int fq) const {
        const int colt = u.pn * BM; bf16_t* base; int ldc;
        if (colt < 1024) { base = gb + colt; ldc = 1024; }
        else if (colt < 2048) { base = gc + (colt - 1024); ldc = 1024; }
        else if (colt < 3072) { base = hv + (colt - 2048); ldc = 1024; }
        else if (colt < 4096) { base = z + (colt - 3072); ldc = 1024; }
        else { base = xbc + (colt - 4096); ldc = 1536; }
        const int row0 = u.pm * BM + wr * 64 + fr, col0 = wc * 32 + 8 * fq;
#pragma unroll
        for (int ai = 0; ai < 2; ++ai)
#pragma unroll
            for (int m = 0; m < 4; ++m) { bf16_t* rowp = base + (size_t)(row0 + ai * HALF + m * 16) * ldc + col0;
#pragma unroll
                for (int bj = 0; bj < 2; ++bj) { const f32x4 v0 = acc[ai][bj][m][0], v1 = acc[ai][bj][m][1];
                    u32x4 w; w.x = cvt_pk_bf16(v0[0], v0[1]); w.y = cvt_pk_bf16(v0[2], v0[3]); w.z = cvt_pk_bf16(v1[0], v1[1]); w.w = cvt_pk_bf16(v1[2], v1[3]);
                    *(u32x4*)(rowp + bj * HALF) = w; } }
    }
};
struct EpiHid {
    static constexpr bool PERM = true, AFTER_DRAIN = false;
    bf16_t* O; int ldc;
    __device__ __forceinline__ void operator()(const f32x4 (&acc)[2][2][4][2], const Unit& u, int wr, int wc, int fr, int fq) const {
        const int row0 = u.pm * BM + wr * 64 + fr, col0 = u.pn * BM + wc * 32 + 8 * fq;
#pragma unroll
        for (int ai = 0; ai < 2; ++ai)
#pragma unroll
            for (int m = 0; m < 4; ++m) { bf16_t* rowp = O + (size_t)(row0 + ai * HALF + m * 16) * ldc + col0;
#pragma unroll
                for (int bj = 0; bj < 2; ++bj) { f32x4 v0 = acc[ai][bj][m][0], v1 = acc[ai][bj][m][1];
#pragma unroll
                    for (int e = 0; e < 4; ++e) { float a = fmaxf(v0[e], 0.f), b = fmaxf(v1[e], 0.f); v0[e] = a * a; v1[e] = b * b; }
                    u32x4 w; w.x = cvt_pk_bf16(v0[0], v0[1]); w.y = cvt_pk_bf16(v0[2], v0[3]); w.z = cvt_pk_bf16(v1[0], v1[1]); w.w = cvt_pk_bf16(v1[2], v1[3]);
                    *(u32x4*)(rowp + bj * HALF) = w; } }
    }
};
struct EpiRes {
    static constexpr bool PERM = false, AFTER_DRAIN = false;
    const float* base; float* out; const float* gate  ; float alpha;
    __device__ __forceinline__ void operator()(const f32x4 (&acc)[2][2][4][2], const Unit& u, int wr, int wc, int fr, int fq) const {
        const int b = (u.pm * BM) >> 11; const float* gp = gate + (size_t)b * 6144;
        const int col0 = u.pn * BM + wc * 32 + 4 * fq;
        f32x4 gv[2][2];
#pragma unroll
        for (int bj = 0; bj < 2; ++bj)
#pragma unroll
            for (int n = 0; n < 2; ++n) { gv[bj][n] = *(const f32x4*)(gp + col0 + bj * HALF + n * 16); gv[bj][n] = gv[bj][n] + 1.0f; }
#pragma unroll
        for (int ai = 0; ai < 2; ++ai)
#pragma unroll
            for (int m = 0; m < 4; ++m) { const size_t off = (size_t)(u.pm * BM + ai * HALF + wr * 64 + m * 16 + fr) * 1024 + col0;
#pragma unroll
                for (int bj = 0; bj < 2; ++bj)
#pragma unroll
                    for (int n = 0; n < 2; ++n) { const f32x4 bs = *(const f32x4*)(base + off + bj * HALF + n * 16);
                        *(f32x4*)(out + off + bj * HALF + n * 16) = bs * alpha + gv[bj][n] * acc[ai][bj][m][n]; } }
    }
};

template <class Epi, class Sched, bool ALIGN_EPI = false, bool SP2 = false>
__device__ __forceinline__ void gemm_phase(PG8_LAS unsigned char* lds, const Gemm g, const Sched& S, const Epi& E) {
    const int tid = threadIdx.x, wid = __builtin_amdgcn_readfirstlane(tid >> 6), lane = tid & 63, wr = wid >> 2, wc = wid & 3, fr = lane & 15, fq = lane >> 4;
    const int K = g.K, nt = K / BK;
    unsigned voffA[2], voffB[2];
#pragma unroll
    for (int i = 0; i < 2; ++i) { int R, C; stage_rc(tid * 16 + i * 8192, R, C); const int Rb = Epi::PERM ? ((R & ~31) + perm32(R & 31)) : R;
        voffA[i] = (unsigned)(R * K + C) * 2u; voffB[i] = (unsigned)(Rb * K + C) * 2u; }
    const size_t kstep = (size_t)(BK * 2);
    const size_t hstep = (size_t)HALF * K * 2;
    const size_t tstep = 2 * hstep;
    const unsigned ldsw = (unsigned)wid * 1024u;
    const int aoff = lds_byte(wr * 64 + fr, fq * 8), boff = lds_byte(wc * 32 + fr, fq * 8);
#define PG8_SA(b, h) (((b) * 2 + (h)) * HTB)
#define PG8_SB(b, h) ((4 + (b) * 2 + (h)) * HTB)
#define PG8_STAGE(bufoff, gbase, voff) do { _Pragma("unroll") for (int _i = 0; _i < 2; ++_i) \
        __builtin_amdgcn_global_load_lds((const unsigned*)((const char*)(gbase) + (voff)[_i]), (PG8_LAS unsigned*)(lds + (bufoff) + ldsw + _i * 8192), 16, 0, 0); } while (0)
#define PG8_LDA(dst, b, h) do { _Pragma("unroll") for (int m = 0; m < 4; ++m) _Pragma("unroll") for (int k = 0; k < 2; ++k) dst[m][k] = *(const PG8_LAS bf16x8*)(lds + PG8_SA(b, h) + aoff + m * 2048 + k * 1024); } while (0)
#define PG8_LDB(dst, b, h) do { _Pragma("unroll") for (int n = 0; n < 2; ++n) _Pragma("unroll") for (int k = 0; k < 2; ++k) dst[n][k] = *(const PG8_LAS bf16x8*)(lds + PG8_SB(b, h) + boff + n * 2048 + k * 1024); } while (0)
#define PG8_MMA(ai, bj, At, Bt) do { __builtin_amdgcn_s_setprio(1); _Pragma("unroll") for (int m = 0; m < 4; ++m) _Pragma("unroll") for (int n = 0; n < 2; ++n) _Pragma("unroll") for (int k = 0; k < 2; ++k) \
        acc[ai][bj][m][n] = __builtin_amdgcn_mfma_f32_16x16x32_bf16(Bt[n][k], At[m][k], acc[ai][bj][m][n], 0, 0, 0); __builtin_amdgcn_s_setprio(0); } while (0)
#define PG8_WAIT_V(n) asm volatile("s_waitcnt vmcnt(" #n ")" ::: "memory")
#define PG8_WAIT_L(n) asm volatile("s_waitcnt lgkmcnt(" #n ")" ::: "memory")
#define PG8_BAR __builtin_amdgcn_s_barrier()
#define PG8_SCHED __builtin_amdgcn_sched_barrier(0)
    Unit cur, nxt; int ui = 0;
    if (!S.next(0, cur)) return;
    f32x4 acc[2][2][4][2];
#pragma unroll
    for (int a = 0; a < 2; ++a)
#pragma unroll
        for (int b = 0; b < 2; ++b)
#pragma unroll
            for (int m = 0; m < 4; ++m)
#pragma unroll
                for (int n = 0; n < 2; ++n) acc[a][b][m][n] = (f32x4){0.f, 0.f, 0.f, 0.f};
    bf16x8 At[4][2], B0[2][2], B1[2][2];
    const char* cA = (const char*)g.A + (size_t)cur.pm * tstep; const char* cB = (const char*)g.Bt + (size_t)cur.pn * tstep;
    S.a_ready(cur);
    if constexpr (SP2) {
        PG8_STAGE(PG8_SB(0, 0), cB, voffB); PG8_STAGE(PG8_SB(0, 1), cB + hstep, voffB); PG8_STAGE(PG8_SA(0, 0), cA, voffA); PG8_STAGE(PG8_SA(0, 1), cA + hstep, voffA);
        if (wr == 1) PG8_BAR;
        PG8_WAIT_V(2); PG8_BAR;
        PG8_STAGE(PG8_SB(1, 0), cB + kstep, voffB); PG8_STAGE(PG8_SA(1, 0), cA + kstep, voffA); PG8_STAGE(PG8_SB(1, 1), cB + hstep + kstep, voffB);
        PG8_WAIT_V(6); PG8_BAR;
    } else {
        PG8_STAGE(PG8_SB(0, 0), cB, voffB); PG8_STAGE(PG8_SA(0, 0), cA, voffA); PG8_STAGE(PG8_SB(0, 1), cB + hstep, voffB); PG8_STAGE(PG8_SA(0, 1), cA + hstep, voffA);
        if (wr == 1) PG8_BAR;
        PG8_WAIT_V(4); PG8_BAR;
        PG8_STAGE(PG8_SB(1, 0), cB + kstep, voffB); PG8_STAGE(PG8_SA(1, 0), cA + kstep, voffA); PG8_STAGE(PG8_SB(1, 1), cB + hstep + kstep, voffB);
        PG8_WAIT_V(6); PG8_BAR;
    }
    for (;;) {
        const bool has_next = S.next(ui + 1, nxt);
        const char* nA = has_next ? (const char*)g.A + (size_t)nxt.pm * tstep : cA; const char* nB = has_next ? (const char*)g.Bt + (size_t)nxt.pn * tstep : cB;
        for (int t = 0; t < nt; t += 2) {
            const bool last = (t == nt - 2);
            const char* a1 = cA + (size_t)(t + 1) * kstep;
            const char* a2 = last ? nA : cA + (size_t)(t + 2) * kstep; const char* b2 = last ? nB : cB + (size_t)(t + 2) * kstep;
            const char* a3 = a2 + kstep; const char* b3 = b2 + kstep;
            if (last && has_next) S.a_ready(nxt);
            if constexpr (SP2) {
            PG8_LDB(B0, 0, 0); PG8_LDB(B1, 0, 1); PG8_SCHED; PG8_LDA(At, 0, 0); PG8_STAGE(PG8_SA(1, 1), a1 + hstep, voffA);
            PG8_WAIT_V(8); PG8_WAIT_L(0); PG8_BAR; PG8_MMA(0, 0, At, B0); PG8_MMA(0, 1, At, B1); PG8_BAR; PG8_SCHED;
            PG8_LDA(At, 0, 1); PG8_STAGE(PG8_SB(0, 0), b2, voffB); PG8_STAGE(PG8_SB(0, 1), b2 + hstep, voffB); PG8_STAGE(PG8_SA(0, 0), a2, voffA);
            PG8_WAIT_V(8); PG8_WAIT_L(0); PG8_BAR; PG8_MMA(1, 0, At, B0); PG8_MMA(1, 1, At, B1); PG8_BAR; PG8_SCHED;
            PG8_LDB(B0, 1, 0); PG8_LDB(B1, 1, 1); PG8_SCHED; PG8_LDA(At, 1, 0); PG8_STAGE(PG8_SA(0, 1), a2 + hstep, voffA);
            PG8_WAIT_V(8); PG8_WAIT_L(0); PG8_BAR; PG8_MMA(0, 0, At, B0); PG8_MMA(0, 1, At, B1); PG8_BAR; PG8_SCHED;
            PG8_LDA(At, 1, 1); PG8_STAGE(PG8_SB(1, 0), b3, voffB); PG8_STAGE(PG8_SB(1, 1), b3 + hstep, voffB); PG8_STAGE(PG8_SA(1, 0), a3, voffA);
            PG8_WAIT_V(8); PG8_WAIT_L(0); PG8_BAR; PG8_MMA(1, 0, At, B0); PG8_MMA(1, 1, At, B1); PG8_BAR; PG8_SCHED;
            } else {
            PG8_LDB(B0, 0, 0); PG8_SCHED; PG8_LDA(At, 0, 0); PG8_STAGE(PG8_SA(1, 1), a1 + hstep, voffA);
            PG8_WAIT_L(8); PG8_BAR; PG8_WAIT_L(0); PG8_MMA(0, 0, At, B0); PG8_BAR; PG8_SCHED;
            PG8_LDB(B1, 0, 1); PG8_STAGE(PG8_SB(0, 0), b2, voffB);
            PG8_BAR; PG8_WAIT_L(0); PG8_MMA(0, 1, At, B1); PG8_BAR;
            PG8_LDA(At, 0, 1); PG8_STAGE(PG8_SA(0, 0), a2, voffA);
            PG8_BAR; PG8_WAIT_L(0); PG8_MMA(1, 0, At, B0); PG8_BAR; PG8_SCHED;
            PG8_STAGE(PG8_SB(0, 1), b2 + hstep, voffB);
            PG8_WAIT_V(6); PG8_BAR; PG8_MMA(1, 1, At, B1); PG8_BAR;
            PG8_LDB(B0, 1, 0); PG8_SCHED; PG8_LDA(At, 1, 0); PG8_STAGE(PG8_SA(0, 1), a2 + hstep, voffA);
            PG8_WAIT_L(8); PG8_BAR; PG8_WAIT_L(0); PG8_MMA(0, 0, At, B0); PG8_BAR; PG8_SCHED;
            PG8_LDB(B1, 1, 1); PG8_STAGE(PG8_SB(1, 0), b3, voffB);
            PG8_BAR; PG8_WAIT_L(0); PG8_MMA(0, 1, At, B1); PG8_BAR;
            PG8_LDA(At, 1, 1); PG8_STAGE(PG8_SA(1, 0), a3, voffA);
            PG8_BAR; PG8_WAIT_L(0); PG8_MMA(1, 0, At, B0); PG8_BAR; PG8_SCHED;
            PG8_STAGE(PG8_SB(1, 1), b3 + hstep, voffB);
            PG8_WAIT_V(6); PG8_BAR; PG8_MMA(1, 1, At, B1); PG8_BAR;
            }
        }
        if constexpr (ALIGN_EPI) { if (wr == 0) PG8_BAR; }
        if constexpr (!Epi::AFTER_DRAIN) { E(acc, cur, wr, wc, fr, fq); S.done(cur); }
        if (!has_next) break;
#pragma unroll
        for (int a = 0; a < 2; ++a)
#pragma unroll
            for (int b = 0; b < 2; ++b)
#pragma unroll
                for (int m = 0; m < 4; ++m)
#pragma unroll
                    for (int n = 0; n < 2; ++n) acc[a][b][m][n] = (f32x4){0.f, 0.f, 0.f, 0.f};
        cur = nxt; cA = nA; cB = nB; ++ui;
        if constexpr (ALIGN_EPI) { if (wr == 1) PG8_BAR; }
    }
    PG8_WAIT_V(0);
    if constexpr (!ALIGN_EPI) { if (wr == 0) PG8_BAR; }
    PG8_BAR;
    if constexpr (Epi::AFTER_DRAIN) { E.fused(acc, cur, wr, wc, fr, fq, lds, wid, lane); S.done(cur); }
#undef PG8_SA
#undef PG8_SB
#undef PG8_STAGE
#undef PG8_LDA
#undef PG8_LDB
#undef PG8_MMA
#undef PG8_WAIT_V
#undef PG8_WAIT_L
#undef PG8_BAR
#undef PG8_SCHED
}
}

#define LAS __attribute__((address_space(3)))
typedef unsigned short bf16_t;
typedef short bf16x8 __attribute__((ext_vector_type(8)));
typedef short bf16x4 __attribute__((ext_vector_type(4)));
typedef float f32x4 __attribute__((ext_vector_type(4)));
typedef unsigned u32x4 __attribute__((ext_vector_type(4)));
typedef unsigned u32x2 __attribute__((ext_vector_type(2)));

constexpr int DM = 1024, NP = 16384, NSMP = 128, NR = NP + NSMP, NINW = 5648, NINM = 5632, XBC = 1536, DFF = 4096, MIX = 2048;
constexpr float ALPHA = 1.189207115002721f, LN_EPS = 1e-5f, RMS_EPS = 1e-5f;
constexpr int NWAVES = 8, NTHREADS = 512;
constexpr int LDS_BYTES = 147456;
constexpr size_t O_Y = 0, O_NCP = 16908288, O_NSCP = 16924672, O_NSP = 16961536, O_NCS = 18010112, O_NSCS = 18272256, O_NSS = 18862080;
constexpr size_t MiB = 1u << 20;
constexpr size_t WS_WADA = 1 * MiB, WS_BT = 1 * MiB, WS_WIN = 13 * MiB, WS_WOUT = 24 * MiB, WS_WUP = 28 * MiB, WS_WDOWN = 36 * MiB;
constexpr size_t WS_CBF = 44 * MiB, WS_MOD = 45 * MiB, WS_DTRAW = 49 * MiB, WS_SXBC = 50 * MiB + 512 * 1024, WS_CDEC = 51 * MiB + 512 * 1024;
constexpr size_t WS_S0 = 52 * MiB, WS_S1 = 85 * MiB, WS_S2 = 118 * MiB, WS_S3 = 151 * MiB, WS_S4 = 200 * MiB, WS_S5 = 233 * MiB;

struct Args {
    const float* in[25]; float* out; unsigned char* ws; int ph_lo, ph_hi;
};
typedef const __attribute__((address_space(4))) Args* CArgs;
#define AP() ({ CArgs _p = (CArgs)__builtin_amdgcn_kernarg_segment_ptr(); asm volatile("" : "+s"(_p)); _p; })

__device__ __forceinline__ unsigned f2bf(float f) { unsigned u = __builtin_bit_cast(unsigned, f); return (u + 0x7fffu + ((u >> 16) & 1u)) >> 16; }
__device__ __forceinline__ unsigned pk2(float lo, float hi) { return pg8::cvt_pk_bf16(lo, hi); }
__device__ __forceinline__ float bflo(unsigned u) { return __builtin_bit_cast(float, u << 16); }
__device__ __forceinline__ float bfhi(unsigned u) { return __builtin_bit_cast(float, u & 0xffff0000u); }
__device__ __forceinline__ void unpack8(const u32x4 v, float* f) { f[0] = bflo(v.x); f[1] = bfhi(v.x); f[2] = bflo(v.y); f[3] = bfhi(v.y); f[4] = bflo(v.z); f[5] = bfhi(v.z); f[6] = bflo(v.w); f[7] = bfhi(v.w); }
__device__ __forceinline__ float wave_sum(float v) {
#pragma unroll
    for (int o = 1; o < 64; o <<= 1) v += __shfl_xor(v, o);
    return v;
}
__device__ __forceinline__ float siluf(float x) { return x / (1.0f + __expf(-x)); }
__device__ __forceinline__ float softplusf(float x) { return x > 20.f ? x : log1pf(__expf(x)); }
#define LDS_FENCE() asm volatile("s_waitcnt lgkmcnt(0)" ::: "memory")

__device__ __forceinline__ void transpose_item(const float* W, int ldw, int nblk, int K, bf16_t* WT, LAS float* scr, int item, int lane) {
    const int kb = item / nblk, nb = item % nblk, k0 = 64 * kb, n0 = 32 * nb;
#pragma unroll 8
    for (int i = 0; i < 32; ++i) { const int kk = 2 * i + (lane >> 5); scr[kk * 33 + (lane & 31)] = W[(size_t)(k0 + kk) * ldw + n0 + (lane & 31)]; }
    LDS_FENCE();
    const int c = lane & 7;
#pragma unroll
    for (int j = 0; j < 4; ++j) { const int n = (lane >> 3) + 8 * j; const LAS float* s = scr + (8 * c) * 33 + n;
        u32x4 o; o.x = pk2(s[0 * 33], s[1 * 33]); o.y = pk2(s[2 * 33], s[3 * 33]); o.z = pk2(s[4 * 33], s[5 * 33]); o.w = pk2(s[6 * 33], s[7 * 33]);
        *(u32x4*)(WT + (size_t)(n0 + n) * K + k0 + 8 * c) = o; }
    LDS_FENCE();
}

template <int KS, class Epi>
__device__ __forceinline__ void small_gemm(LAS float* red, const bf16_t* A, int lda, const bf16_t* Bt, int ldb, int Mtiles, int ntiles_total, int K, const Epi& epi, int it0, int itstride) {
    const int tid = threadIdx.x, wave = __builtin_amdgcn_readfirstlane(tid >> 6), lane = tid & 63, r16 = lane & 15, quad = lane >> 4;
    constexpr int TPW = 8 / KS;
    const int sub = wave / KS, ks = wave % KS, kchunk = K / KS;
    const int niter = (ntiles_total + TPW - 1) / TPW;
    for (int it = it0; it < niter; it += itstride) {
        const int tile = it * TPW + sub; const bool valid = tile < ntiles_total;
        f32x4 acc = {0.f, 0.f, 0.f, 0.f}; int mt = 0, nt = 0;
        if (valid) {
            mt = tile % Mtiles; nt = tile / Mtiles;
            const bf16_t* ap = A + (size_t)(mt * 16 + r16) * lda + ks * kchunk + quad * 8;
            const bf16_t* bp = Bt + (size_t)(nt * 16 + r16) * ldb + ks * kchunk + quad * 8;
            for (int k = 0; k < kchunk; k += 256) {
                bf16x8 a[8], b[8];
#pragma unroll
                for (int j = 0; j < 8; ++j) { a[j] = *(const bf16x8*)(ap + k + j * 32); b[j] = *(const bf16x8*)(bp + k + j * 32); }
#pragma unroll
                for (int j = 0; j < 8; ++j) acc = __builtin_amdgcn_mfma_f32_16x16x32_bf16(b[j], a[j], acc, 0, 0, 0);
            }
        }
        if constexpr (KS > 1) {
            *(LAS f32x4*)(red + (wave * 64 + lane) * 4) = acc;
            __syncthreads();
            if (ks == 0) {
#pragma unroll
                for (int q = 1; q < KS; ++q) acc += *(const LAS f32x4*)(red + ((wave + q) * 64 + lane) * 4);
            }
            __syncthreads();
        }
        if (valid && ks == 0) epi(mt * 16 + r16, nt * 16 + quad * 4, acc);
    }
}
struct EpiMod { float* mod; const float* b_ada;
    __device__ __forceinline__ void operator()(int row, int col, f32x4 v) const { if (row < 136) *(f32x4*)(mod + (size_t)row * 6144 + col) = v + *(const f32x4*)(b_ada + col); } };
struct EpiProjS { bf16_t *gb, *gc, *hv, *z, *xbc;
    __device__ __forceinline__ void operator()(int row, int col, f32x4 v) const {
        bf16_t* base; int ldc; int c = col;
        if (c < 1024) { base = gb; ldc = 1024; } else if (c < 2048) { base = gc; c -= 1024; ldc = 1024; } else if (c < 3072) { base = hv; c -= 2048; ldc = 1024; }
        else if (c < 4096) { base = z; c -= 3072; ldc = 1024; } else { base = xbc; c -= 4096; ldc = 1536; }
        u32x2 w; w.x = pk2(v[0], v[1]); w.y = pk2(v[2], v[3]); *(u32x2*)(base + (size_t)(NP + row) * ldc + c) = w; } };
struct EpiHidS { bf16_t* O;
    __device__ __forceinline__ void operator()(int row, int col, f32x4 v) const {
#pragma unroll
        for (int e = 0; e < 4; ++e) { const float a = fmaxf(v[e], 0.f); v[e] = a * a; }
        u32x2 w; w.x = pk2(v[0], v[1]); w.y = pk2(v[2], v[3]); *(u32x2*)(O + (size_t)(NP + row) * DFF + col) = w; } };
struct EpiResS { const float* base  ; float* out; const float* gate  ;
    __device__ __forceinline__ void operator()(int row, int col, f32x4 v) const {
        const f32x4 g = *(const f32x4*)(gate + (size_t)row * 6144 + col) + 1.0f; const f32x4 bs = *(const f32x4*)(base + (size_t)row * 1024 + col);
        *(f32x4*)(out + (size_t)row * 1024 + col) = bs * ALPHA + g * v; } };

__device__ __forceinline__ void dt_scan(const float* dtraw, int rowbase, int h, float dtb, float a, int lane, float& dt0, float& dt1, float& acs0, float& acs1, float& total) {
    const float r0 = dtraw[(size_t)(rowbase + 2 * lane) * 16 + h] + dtb, r1 = dtraw[(size_t)(rowbase + 2 * lane + 1) * 16 + h] + dtb;
    dt0 = softplusf(r0); dt1 = softplusf(r1);
    const float d0 = dt0 * a, d1 = dt1 * a;
    float incl = d0 + d1;
#pragma unroll
    for (int o = 1; o < 64; o <<= 1) { const float t = __shfl_up(incl, o); if (lane >= o) incl += t; }
    const float excl = incl - (d0 + d1);
    acs0 = excl + d0; acs1 = excl + d0 + d1;
    total = __shfl(incl, 63);
}

__device__ __forceinline__ void ln_row(const float* xrow, const float* g, const float* bta, int lane, f32x4 (&v)[4]) {
    const f32x4* xr = (const f32x4*)xrow + lane; float s = 0.f;
#pragma unroll
    for (int j = 0; j < 4; ++j) { v[j] = xr[64 * j]; s += (v[j].x + v[j].y) + (v[j].z + v[j].w); }
    const float mean = wave_sum(s) * (1.f / DM); float s2 = 0.f;
#pragma unroll
    for (int j = 0; j < 4; ++j) { v[j] = v[j] - mean; s2 += (v[j].x * v[j].x + v[j].y * v[j].y) + (v[j].z * v[j].z + v[j].w * v[j].w); }
    const float rstd = 1.f / sqrtf(wave_sum(s2) * (1.f / DM) + LN_EPS);
#pragma unroll
    for (int j = 0; j < 4; ++j) { const f32x4 gg = *((const f32x4*)g + lane + 64 * j), bb = *((const f32x4*)bta + lane + 64 * j); v[j] = v[j] * rstd * gg + bb; }
}

__global__ void __launch_bounds__(NTHREADS, 2) mk_fwd(Args args) {
    extern __shared__ __attribute__((aligned(16))) unsigned char lds[];
    LAS unsigned char* const L = (LAS unsigned char*)lds;
    const int tid = threadIdx.x, lane = tid & 63, wave = __builtin_amdgcn_readfirstlane(tid >> 6);
    const int G = gridDim.x, bid = blockIdx.x;
    const int gw = bid * NWAVES + wave, NGW = G * NWAVES;
#define dout (A_->out)
#define x_prompt (A_->in[0])
#define x_sample (A_->in[1])
#define state_conv (A_->in[2])
#define state_ssm_conv (A_->in[3])
#define state_ssm (A_->in[4])
#define c_prompt (A_->in[5])
#define c_sample (A_->in[6])
#define w_ada (A_->in[7])
#define b_ada (A_->in[8])
#define w_in (A_->in[9])
#define conv_w (A_->in[10])
#define conv_norm_w (A_->in[11])
#define ssm_conv_w (A_->in[12])
#define ssm_conv_b (A_->in[13])
#define dt_bias (A_->in[14])
#define a_log (A_->in[15])
#define d_skip (A_->in[16])
#define ssm_norm_w (A_->in[17])
#define w_out (A_->in[18])
#define ln1_g (A_->in[19])
#define ln1_b (A_->in[20])
#define w_up (A_->in[21])
#define w_down (A_->in[22])
#define ln2_g (A_->in[23])
#define ln2_b (A_->in[24])
#define WadaT ((bf16_t*)(A_->ws + WS_WADA))
#define WinT ((bf16_t*)(A_->ws + WS_WIN))
#define WoutT ((bf16_t*)(A_->ws + WS_WOUT))
#define WupT ((bf16_t*)(A_->ws + WS_WUP))
#define WdownT ((bf16_t*)(A_->ws + WS_WDOWN))
#define cbf ((bf16_t*)(A_->ws + WS_CBF))
#define mod ((float*)(A_->ws + WS_MOD))
#define dtraw ((float*)(A_->ws + WS_DTRAW))
#define sxbc ((float*)(A_->ws + WS_SXBC))
#define cdec ((float*)(A_->ws + WS_CDEC))
#define ubf ((bf16_t*)(A_->ws + WS_S0))
#define xT ((bf16_t*)(A_->ws + WS_S0))
#define vbf ((bf16_t*)(A_->ws + WS_S0))
#define gbB ((bf16_t*)(A_->ws + WS_S1))
#define CS ((float*)(A_->ws + WS_S1))
#define pre1 ((float*)(A_->ws + WS_S1))
#define hid ((bf16_t*)(A_->ws + WS_S1))
#define hvB ((bf16_t*)(A_->ws + WS_S2))
#define xbcB ((bf16_t*)(A_->ws + WS_S3))
#define Sprev ((bf16_t*)(A_->ws + WS_S3))
#define zB ((bf16_t*)(A_->ws + WS_S4))
#define BC ((bf16_t*)(A_->ws + WS_S5))
#define BT ((bf16_t*)(A_->ws + WS_BT))
#define gcB ((bf16_t*)(A_->out + O_NSS))
#define ymix ((bf16_t*)(A_->out + O_Y))
#define Yf (A_->out + O_Y)
    const int lo = args.ph_lo, hi = args.ph_hi;
#define IN(k) (lo <= (k) && (k) < hi)
#define SEAM(k) do { if (IN(k) && IN((k) + 1)) { cg::this_grid().sync(); } } while (0)

    if (IN(0)) { CArgs A_ = AP();
        LAS float* scr = (LAS float*)(L + wave * 16384);
        constexpr int I_ADA = 16 * 192, I_IN = 16 * 176, I_OUT = 32 * 32, I_UP = 16 * 128, I_DOWN = 64 * 32;
        constexpr int NITEMS = I_ADA + I_IN + I_OUT + I_UP + I_DOWN;
        for (int it = gw; it < NITEMS; it += NGW) {
            int r = it;
            if (r < I_ADA) { transpose_item(w_ada, 6144, 192, 1024, WadaT, scr, r, lane); continue; } r -= I_ADA;
            if (r < I_IN) { transpose_item(w_in, NINW, 176, 1024, WinT, scr, r, lane); continue; } r -= I_IN;
            if (r < I_OUT) { transpose_item(w_out, 1024, 32, 2048, WoutT, scr, r, lane); continue; } r -= I_OUT;
            if (r < I_UP) { transpose_item(w_up, 4096, 128, 1024, WupT, scr, r, lane); continue; } r -= I_UP;
            transpose_item(w_down, 1024, 32, 4096, WdownT, scr, r, lane);
        }
        for (int r = gw; r < 144; r += NGW) {
            const float* src = r < 8 ? c_prompt + (size_t)r * DM : c_sample + (size_t)(r - 8) * DM;
#pragma unroll
            for (int j = 0; j < 4; ++j) { f32x4 v = {0.f, 0.f, 0.f, 0.f}; if (r < 136) v = *((const f32x4*)src + lane + 64 * j);
                u32x2 w; w.x = pk2(v.x, v.y); w.y = pk2(v.z, v.w); *((u32x2*)(cbf + (size_t)r * DM) + lane + 64 * j) = w; }
        }
    }
    SEAM(0);
    if (IN(1)) { CArgs A_ = AP();
        EpiMod E{mod, b_ada};
        small_gemm<1>((LAS float*)L, cbf, DM, WadaT, DM, 9, 9 * 384, 1024, E, bid, G);
    }
    SEAM(1);
    if (IN(2)) { CArgs A_ = AP();
        LAS float* w16 = (LAS float*)L;
        for (int i = tid; i < 4096; i += NTHREADS) { const int k = i >> 2, c4 = i & 3; *(LAS f32x4*)(w16 + k * 20 + c4 * 4) = *(const f32x4*)(w_in + (size_t)k * NINW + NINM + c4 * 4); }
        __syncthreads();
        for (int r = gw; r < NR; r += NGW) {
            const float* xrow = r < NP ? x_prompt + (size_t)r * DM : x_sample + (size_t)(r - NP) * DM;
            const float* mrow = mod + (size_t)(r < NP ? (r >> 11) : 8 + r - NP) * 6144;
            float acc[16];
#pragma unroll
            for (int c = 0; c < 16; ++c) acc[c] = 0.f;
#pragma unroll
            for (int j = 0; j < 4; ++j) {
                const f32x4 xv = *((const f32x4*)xrow + lane + 64 * j), sh = *((const f32x4*)mrow + lane + 64 * j), sc = *((const f32x4*)(mrow + 1024) + lane + 64 * j);
                const f32x4 u = xv * (sc + 1.0f) + sh;
                u32x2 w; w.x = pk2(u.x, u.y); w.y = pk2(u.z, u.w); *((u32x2*)(ubf + (size_t)r * DM) + lane + 64 * j) = w;
#pragma unroll
                for (int e = 0; e < 4; ++e) { const int k = 256 * j + 4 * lane + e; const LAS f32x4* wp = (const LAS f32x4*)(w16 + k * 20);
#pragma unroll
                    for (int c4 = 0; c4 < 4; ++c4) { const f32x4 wv = wp[c4];
#pragma unroll
                        for (int q = 0; q < 4; ++q) acc[c4 * 4 + q] += u[e] * wv[q]; } }
            }
#pragma unroll
            for (int c = 0; c < 16; ++c) acc[c] = wave_sum(acc[c]);
            if (lane == 0) {
#pragma unroll
                for (int c4 = 0; c4 < 4; ++c4) *(f32x4*)(dtraw + (size_t)r * 16 + c4 * 4) = (f32x4){acc[c4 * 4], acc[c4 * 4 + 1], acc[c4 * 4 + 2], acc[c4 * 4 + 3]};
            }
        }
        __syncthreads();
    }
    SEAM(2);
    if (IN(3)) { CArgs A_ = AP();
        pg8::Gemm g{ubf, WinT, NP, NINM, DM}; pg8::StaticOrder S; S.init(NP, NINM, G, bid);
        pg8::EpiProj E{gbB, gcB, hvB, zB, xbcB};
        pg8::gemm_phase<pg8::EpiProj, pg8::StaticOrder, true, true>(L, g, S, E);
        __syncthreads();
        EpiProjS ES{gbB, gcB, hvB, zB, xbcB};
        small_gemm<1>((LAS float*)L, ubf + (size_t)NP * DM, DM, WinT, DM, 8, 8 * 352, 1024, ES, (bid + 128) % G, G);
    }
    SEAM(3);
    if (IN(4)) { CArgs A_ = AP();
        for (int T = gw; T < 2048 + 128; T += NGW) {
            const bool smp = T >= 2048; const int row0 = smp ? NP + (T - 2048) : T * 8, n = smp ? 1 : 8;
            const int b = row0 >> 11, t0 = row0 & 2047, c0 = 16 * lane;
            float cw[3][16], nw[16], p1[16], p2[16];
#pragma unroll
            for (int k = 0; k < 3; ++k)
#pragma unroll
                for (int q = 0; q < 4; ++q) { const f32x4 v = *(const f32x4*)(conv_w + k * 1024 + c0 + 4 * q); cw[k][4 * q] = v.x; cw[k][4 * q + 1] = v.y; cw[k][4 * q + 2] = v.z; cw[k][4 * q + 3] = v.w; }
#pragma unroll
            for (int q = 0; q < 4; ++q) { const f32x4 v = *(const f32x4*)(conv_norm_w + c0 + 4 * q); nw[4 * q] = v.x; nw[4 * q + 1] = v.y; nw[4 * q + 2] = v.z; nw[4 * q + 3] = v.w; }
            if (smp) {
                const float* st = state_conv + (size_t)(T - 2048) * 2048 + c0;
#pragma unroll
                for (int q = 0; q < 4; ++q) { const f32x4 a = *(const f32x4*)(st + 4 * q), bb = *(const f32x4*)(st + 1024 + 4 * q);
                    p2[4 * q] = a.x; p2[4 * q + 1] = a.y; p2[4 * q + 2] = a.z; p2[4 * q + 3] = a.w; p1[4 * q] = bb.x; p1[4 * q + 1] = bb.y; p1[4 * q + 2] = bb.z; p1[4 * q + 3] = bb.w; }
            } else if (t0 == 0) {
#pragma unroll
                for (int e = 0; e < 16; ++e) { p1[e] = 0.f; p2[e] = 0.f; }
            } else {
#pragma unroll
                for (int hh = 0; hh < 2; ++hh) {
                    float a[16], bb[16];
                    const size_t o2 = (size_t)(row0 - 2) * 1024 + c0 + 8 * hh, o1 = (size_t)(row0 - 1) * 1024 + c0 + 8 * hh;
                    unpack8(*(const u32x4*)(gcB + o2), a); unpack8(*(const u32x4*)(hvB + o2), a + 8);
                    unpack8(*(const u32x4*)(gcB + o1), bb); unpack8(*(const u32x4*)(hvB + o1), bb + 8);
#pragma unroll
                    for (int e = 0; e < 8; ++e) { p2[8 * hh + e] = a[e] * a[8 + e]; p1[8 * hh + e] = bb[e] * bb[8 + e]; }
                }
            }
            for (int i = 0; i < n; ++i) {
                const int row = row0 + i; float gv[16], cv[16], hv[16], ch[16], y[16];
                const size_t o = (size_t)row * 1024 + c0;
                unpack8(*(const u32x4*)(gbB + o), gv); unpack8(*(const u32x4*)(gbB + o + 8), gv + 8);
                unpack8(*(const u32x4*)(gcB + o), cv); unpack8(*(const u32x4*)(gcB + o + 8), cv + 8);
                unpack8(*(const u32x4*)(hvB + o), hv); unpack8(*(const u32x4*)(hvB + o + 8), hv + 8);
                float ss = 0.f;
#pragma unroll
                for (int e = 0; e < 16; ++e) { ch[e] = cv[e] * hv[e]; const float c3 = cw[0][e] * p2[e] + cw[1][e] * p1[e] + cw[2][e] * ch[e]; y[e] = gv[e] * c3; ss += y[e] * y[e]; }
                ss += __shfl_xor(ss, 1); ss += __shfl_xor(ss, 2);
                const float rstd = 1.0f / sqrtf(ss * (1.f / 64.f) + RMS_EPS);
                u32x4 w0, w1;
                w0.x = pk2(y[0] * rstd * nw[0], y[1] * rstd * nw[1]); w0.y = pk2(y[2] * rstd * nw[2], y[3] * rstd * nw[3]); w0.z = pk2(y[4] * rstd * nw[4], y[5] * rstd * nw[5]); w0.w = pk2(y[6] * rstd * nw[6], y[7] * rstd * nw[7]);
                w1.x = pk2(y[8] * rstd * nw[8], y[9] * rstd * nw[9]); w1.y = pk2(y[10] * rstd * nw[10], y[11] * rstd * nw[11]); w1.z = pk2(y[12] * rstd * nw[12], y[13] * rstd * nw[13]); w1.w = pk2(y[14] * rstd * nw[14], y[15] * rstd * nw[15]);
                *(u32x4*)(ymix + (size_t)row * MIX + c0) = w0; *(u32x4*)(ymix + (size_t)row * MIX + c0 + 8) = w1;
                if (smp) {
                    float* o0 = dout + O_NCS + (size_t)(T - 2048) * 2048 + c0;
#pragma unroll
                    for (int q = 0; q < 4; ++q) { *(f32x4*)(o0 + 4 * q) = (f32x4){p1[4 * q], p1[4 * q + 1], p1[4 * q + 2], p1[4 * q + 3]}; *(f32x4*)(o0 + 1024 + 4 * q) = (f32x4){ch[4 * q], ch[4 * q + 1], ch[4 * q + 2], ch[4 * q + 3]}; }
                } else if (t0 + i >= 2046) {
                    float* o0 = dout + O_NCP + (size_t)(b * 2 + (t0 + i - 2046)) * 1024 + c0;
#pragma unroll
                    for (int q = 0; q < 4; ++q) *(f32x4*)(o0 + 4 * q) = (f32x4){ch[4 * q], ch[4 * q + 1], ch[4 * q + 2], ch[4 * q + 3]};
                }
#pragma unroll
                for (int e = 0; e < 16; ++e) { p2[e] = p1[e]; p1[e] = ch[e]; }
            }
        }
        for (int T = gw; T < 3 * (2048 + 128); T += NGW) {
            const int j = T % 3, strip = T / 3; const bool smp = strip >= 2048;
            const int row0 = smp ? NP + (strip - 2048) : strip * 8;
            const int b = row0 >> 11, t0 = row0 & 2047, c0 = j * 512 + 8 * lane;
            float w[4][8], bias[8], q1[8], q2[8], q3[8];
#pragma unroll
            for (int k = 0; k < 4; ++k) { const f32x4 a = *(const f32x4*)(ssm_conv_w + k * XBC + c0), bb = *(const f32x4*)(ssm_conv_w + k * XBC + c0 + 4);
                w[k][0] = a.x; w[k][1] = a.y; w[k][2] = a.z; w[k][3] = a.w; w[k][4] = bb.x; w[k][5] = bb.y; w[k][6] = bb.z; w[k][7] = bb.w; }
            { const f32x4 a = *(const f32x4*)(ssm_conv_b + c0), bb = *(const f32x4*)(ssm_conv_b + c0 + 4);
              bias[0] = a.x; bias[1] = a.y; bias[2] = a.z; bias[3] = a.w; bias[4] = bb.x; bias[5] = bb.y; bias[6] = bb.z; bias[7] = bb.w; }
            if (smp) {
                const int sb = strip - 2048; const float* st = state_ssm_conv + (size_t)sb * 3 * XBC + c0;
#pragma unroll
                for (int e = 0; e < 8; ++e) { q3[e] = st[e]; q2[e] = st[XBC + e]; q1[e] = st[2 * XBC + e]; }
                float cur[8]; unpack8(*(const u32x4*)(xbcB + (size_t)row0 * XBC + c0), cur);
                float val[8];
#pragma unroll
                for (int e = 0; e < 8; ++e) val[e] = siluf(w[0][e] * q3[e] + w[1][e] * q2[e] + w[2][e] * q1[e] + w[3][e] * cur[e] + bias[e]);
                *(f32x4*)(sxbc + (size_t)sb * XBC + c0) = (f32x4){val[0], val[1], val[2], val[3]}; *(f32x4*)(sxbc + (size_t)sb * XBC + c0 + 4) = (f32x4){val[4], val[5], val[6], val[7]};
                float* o0 = dout + O_NSCS + (size_t)sb * 3 * XBC + c0;
                *(f32x4*)(o0) = (f32x4){q2[0], q2[1], q2[2], q2[3]}; *(f32x4*)(o0 + 4) = (f32x4){q2[4], q2[5], q2[6], q2[7]};
                *(f32x4*)(o0 + XBC) = (f32x4){q1[0], q1[1], q1[2], q1[3]}; *(f32x4*)(o0 + XBC + 4) = (f32x4){q1[4], q1[5], q1[6], q1[7]};
                *(f32x4*)(o0 + 2 * XBC) = (f32x4){cur[0], cur[1], cur[2], cur[3]}; *(f32x4*)(o0 + 2 * XBC + 4) = (f32x4){cur[4], cur[5], cur[6], cur[7]};
            } else {
                if (t0 == 0) {
#pragma unroll
                    for (int e = 0; e < 8; ++e) { q1[e] = 0.f; q2[e] = 0.f; q3[e] = 0.f; }
                } else {
                    unpack8(*(const u32x4*)(xbcB + (size_t)(row0 - 3) * XBC + c0), q3); unpack8(*(const u32x4*)(xbcB + (size_t)(row0 - 2) * XBC + c0), q2); unpack8(*(const u32x4*)(xbcB + (size_t)(row0 - 1) * XBC + c0), q1);
                }
                unsigned ov[8][4];
                float prev[8];
#pragma unroll
                for (int i = 0; i < 8; ++i) {
                    const int row = row0 + i; float cur[8], val[8];
                    unpack8(*(const u32x4*)(xbcB + (size_t)row * XBC + c0), cur);
#pragma unroll
                    for (int e = 0; e < 8; ++e) val[e] = siluf(w[0][e] * q3[e] + w[1][e] * q2[e] + w[2][e] * q1[e] + w[3][e] * cur[e] + bias[e]);
                    if (j == 2) { u32x4 o; o.x = pk2(val[0], val[1]); o.y = pk2(val[2], val[3]); o.z = pk2(val[4], val[5]); o.w = pk2(val[6], val[7]); *(u32x4*)(BC + (size_t)row * 512 + 8 * lane) = o; }
                    if (i & 1) {
#pragma unroll
                        for (int e = 0; e < 8; ++e) ov[e][i >> 1] = pk2(prev[e], val[e]);
                    } else {
#pragma unroll
                        for (int e = 0; e < 8; ++e) prev[e] = val[e];
                    }
                    if (t0 + i >= 2045) { float* o0 = dout + O_NSCP + (size_t)(b * 3 + (t0 + i - 2045)) * XBC + c0;
                        *(f32x4*)(o0) = (f32x4){cur[0], cur[1], cur[2], cur[3]}; *(f32x4*)(o0 + 4) = (f32x4){cur[4], cur[5], cur[6], cur[7]}; }
#pragma unroll
                    for (int e = 0; e < 8; ++e) { q3[e] = q2[e]; q2[e] = q1[e]; q1[e] = cur[e]; }
                }
                const int chunk = t0 >> 7, s0 = t0 & 127;
                if (j < 2) {
#pragma unroll
                    for (int e = 0; e < 8; ++e) *(u32x4*)(xT + ((size_t)((b * 16 + chunk) * 1024 + c0 + e)) * 128 + s0) = (u32x4){ov[e][0], ov[e][1], ov[e][2], ov[e][3]};
                } else if (lane < 32) {
#pragma unroll
                    for (int e = 0; e < 8; ++e) *(u32x4*)(BT + ((size_t)((b * 16 + chunk) * 256 + 8 * lane + e)) * 128 + s0) = (u32x4){ov[e][0], ov[e][1], ov[e][2], ov[e][3]};
                }
            }
        }
    }
    SEAM(4);
    if (IN(5)) { CArgs A_ = AP();
        LAS float* wl = (LAS float*)(L + wave * 512);
        const int r16 = lane & 15, quad = lane >> 4;
        for (int item = bid; item < 2048; item += G) {
            const int h = item & 15, bc = item >> 4, g = h >> 3, rowbase = bc * 128;
            float dt0, dt1, a0, a1, tot; const float aa = -__expf(a_log[h]);
            dt_scan(dtraw, rowbase, h, dt_bias[h], aa, lane, dt0, dt1, a0, a1, tot);
            wl[2 * lane] = dt0 * __expf(tot - a0); wl[2 * lane + 1] = dt1 * __expf(tot - a1);
            if (wave == 0 && lane == 0) cdec[item] = __expf(tot);
            LDS_FENCE();
            f32x4 acc[4];
#pragma unroll
            for (int pt = 0; pt < 4; ++pt) acc[pt] = (f32x4){0.f, 0.f, 0.f, 0.f};
            const bf16_t* btp = BT + ((size_t)(bc * 256 + g * 128 + 16 * wave + r16)) * 128 + quad * 8;
            const bf16_t* xtp = xT + ((size_t)(bc * 1024 + h * 64 + r16)) * 128 + quad * 8;
#pragma unroll
            for (int kk = 0; kk < 4; ++kk) {
                const f32x4 wa = *(const LAS f32x4*)(wl + 32 * kk + quad * 8), wb = *(const LAS f32x4*)(wl + 32 * kk + quad * 8 + 4);
                const bf16x8 bfr = *(const bf16x8*)(btp + 32 * kk);
#pragma unroll
                for (int pt = 0; pt < 4; ++pt) {
                    const u32x4 raw = *(const u32x4*)(xtp + (size_t)pt * 16 * 128 + 32 * kk);
                    u32x4 sc; sc.x = pk2(bflo(raw.x) * wa.x, bfhi(raw.x) * wa.y); sc.y = pk2(bflo(raw.y) * wa.z, bfhi(raw.y) * wa.w);
                    sc.z = pk2(bflo(raw.z) * wb.x, bfhi(raw.z) * wb.y); sc.w = pk2(bflo(raw.w) * wb.z, bfhi(raw.w) * wb.w);
                    acc[pt] = __builtin_amdgcn_mfma_f32_16x16x32_bf16(bfr, __builtin_bit_cast(bf16x8, sc), acc[pt], 0, 0, 0);
                }
            }
#pragma unroll
            for (int pt = 0; pt < 4; ++pt) *(f32x4*)(CS + (size_t)item * 8192 + (pt * 16 + r16) * 128 + 16 * wave + quad * 4) = acc[pt];
            LDS_FENCE();
        }
    }
    SEAM(5);
    if (IN(6)) { CArgs A_ = AP();
        for (int e = bid * NTHREADS + tid; e < 262144; e += G * NTHREADS) {
            const int n4 = e & 31, p = (e >> 5) & 63, h = (e >> 11) & 15, b = e >> 15;
            f32x4 cs[16]; float dc[16];
#pragma unroll
            for (int c = 0; c < 16; ++c) { cs[c] = *(const f32x4*)(CS + ((size_t)((b * 16 + c) * 16 + h)) * 8192 + p * 128 + n4 * 4); dc[c] = cdec[(b * 16 + c) * 16 + h]; }
            f32x4 S = {0.f, 0.f, 0.f, 0.f};
#pragma unroll
            for (int c = 0; c < 16; ++c) {
                u32x2 w; w.x = pk2(S.x, S.y); w.y = pk2(S.z, S.w);
                *(u32x2*)(Sprev + ((size_t)((b * 16 + c) * 16 + h)) * 8192 + p * 128 + n4 * 4) = w;
                S = S * dc[c] + cs[c];
            }
            *(f32x4*)(dout + O_NSP + ((size_t)((b * 16 + h) * 64 + p)) * 128 + n4 * 4) = S;
        }
    }
    SEAM(6);
    if (IN(7)) { CArgs A_ = AP();
        LAS unsigned char* ysh = L + wave * (16 * 1032);
        LAS float* ldt = (LAS float*)(L + 132096); LAS float* lacs = (LAS float*)(L + 136192); LAS float* red = (LAS float*)(L + 140288);
        const int r16 = lane & 15, quad = lane >> 4;
        for (int item = bid; item < 256; item += G) {
            const int g = item & 1, bc = item >> 1, rowbase = bc * 128;
            { const int h = g * 8 + wave; float dt0, dt1, a0, a1, tot; const float aa = -__expf(a_log[h]);
              dt_scan(dtraw, rowbase, h, dt_bias[h], aa, lane, dt0, dt1, a0, a1, tot);
              ldt[wave * 128 + 2 * lane] = dt0; ldt[wave * 128 + 2 * lane + 1] = dt1; lacs[wave * 128 + 2 * lane] = a0; lacs[wave * 128 + 2 * lane + 1] = a1; }
            __syncthreads();
            const bf16_t* BCp = BC + (size_t)rowbase * 512;
            const int srow = 16 * wave + r16;
            bf16x8 cfr[4];
#pragma unroll
            for (int kk = 0; kk < 4; ++kk) cfr[kk] = *(const bf16x8*)(BCp + (size_t)srow * 512 + 256 + g * 128 + 32 * kk + quad * 8);
            f32x4 cbt[8];
#pragma unroll
            for (int tt = 0; tt < 8; ++tt) { cbt[tt] = (f32x4){0.f, 0.f, 0.f, 0.f};
                if (tt <= wave) {
#pragma unroll
                    for (int kk = 0; kk < 4; ++kk) { const bf16x8 bfr = *(const bf16x8*)(BCp + (size_t)(16 * tt + r16) * 512 + g * 128 + 32 * kk + quad * 8);
                        cbt[tt] = __builtin_amdgcn_mfma_f32_16x16x32_bf16(bfr, cfr[kk], cbt[tt], 0, 0, 0); } } }
            float ss = 0.f;
            for (int hh = 0; hh < 8; ++hh) {
                const int h = g * 8 + hh; const float acs_s = lacs[hh * 128 + srow], dsk = d_skip[h];
                bf16x8 gfr[4];
#pragma unroll
                for (int kk = 0; kk < 4; ++kk) {
                    unsigned pk[4];
#pragma unroll
                    for (int half = 0; half < 2; ++half) { const int tt = 2 * kk + half;
                        const f32x4 at = *(const LAS f32x4*)(lacs + hh * 128 + 16 * tt + quad * 4), dtt = *(const LAS f32x4*)(ldt + hh * 128 + 16 * tt + quad * 4);
                        float v[4];
#pragma unroll
                        for (int r = 0; r < 4; ++r) { const int t = 16 * tt + quad * 4 + r; float x = 0.f;
                            if (t <= srow) x = cbt[tt][r] * __expf(acs_s - at[r]) * dtt[r];
                            if (t == srow) x += dsk;
                            v[r] = x; }
                        pk[2 * half] = pk2(v[0], v[1]); pk[2 * half + 1] = pk2(v[2], v[3]); }
                    gfr[kk] = __builtin_bit_cast(bf16x8, (u32x4){pk[0], pk[1], pk[2], pk[3]});
                }
                f32x4 yd[4], yo[4];
#pragma unroll
                for (int pt = 0; pt < 4; ++pt) { yd[pt] = (f32x4){0.f, 0.f, 0.f, 0.f}; yo[pt] = (f32x4){0.f, 0.f, 0.f, 0.f}; }
                const bf16_t* xtp = xT + ((size_t)(bc * 1024 + h * 64 + r16)) * 128 + quad * 4;
                const bf16_t* spp = Sprev + ((size_t)(bc * 16 + h)) * 8192 + (size_t)r16 * 128 + quad * 8;
#pragma unroll
                for (int kk = 0; kk < 4; ++kk) {
                    if (2 * kk <= wave) {
#pragma unroll
                        for (int pt = 0; pt < 4; ++pt) { const u32x2 lo2 = *(const u32x2*)(xtp + (size_t)pt * 2048 + 32 * kk), hi2 = *(const u32x2*)(xtp + (size_t)pt * 2048 + 32 * kk + 16);
                            yd[pt] = __builtin_amdgcn_mfma_f32_16x16x32_bf16(__builtin_bit_cast(bf16x8, (u32x4){lo2.x, lo2.y, hi2.x, hi2.y}), gfr[kk], yd[pt], 0, 0, 0); }
                    }
#pragma unroll
                    for (int pt = 0; pt < 4; ++pt) { const bf16x8 sa = *(const bf16x8*)(spp + (size_t)pt * 2048 + 32 * kk);
                        yo[pt] = __builtin_amdgcn_mfma_f32_16x16x32_bf16(sa, cfr[kk], yo[pt], 0, 0, 0); }
                }
                const float es = __expf(acs_s);
#pragma unroll
                for (int pt = 0; pt < 4; ++pt) {
                    const u32x2 zr = *(const u32x2*)(zB + (size_t)(rowbase + srow) * 1024 + h * 64 + pt * 16 + quad * 4);
                    const float z0 = bflo(zr.x), z1 = bfhi(zr.x), z2 = bflo(zr.y), z3 = bfhi(zr.y);
                    const float y0 = (yd[pt][0] + es * yo[pt][0]) * siluf(z0), y1 = (yd[pt][1] + es * yo[pt][1]) * siluf(z1);
                    const float y2 = (yd[pt][2] + es * yo[pt][2]) * siluf(z2), y3 = (yd[pt][3] + es * yo[pt][3]) * siluf(z3);
                    ss += (y0 * y0 + y1 * y1) + (y2 * y2 + y3 * y3);
                    *(LAS u32x2*)(ysh + r16 * 1032 + (hh * 64 + pt * 16 + quad * 4) * 2) = (u32x2){pk2(y0, y1), pk2(y2, y3)};
                }
            }
            ss += __shfl_xor(ss, 16); ss += __shfl_xor(ss, 32);
            const float rstd = 1.0f / sqrtf(ss * (1.f / 512.f) + RMS_EPS);
            LDS_FENCE();
#pragma unroll 4
            for (int q = 0; q < 32; ++q) {
                const u32x2 yr = *(const LAS u32x2*)(ysh + r16 * 1032 + (q * 16 + quad * 4) * 2);
                const f32x4 nwv = *(const f32x4*)(ssm_norm_w + g * 512 + q * 16 + quad * 4);
                u32x2 o; o.x = pk2(bflo(yr.x) * rstd * nwv.x, bfhi(yr.x) * rstd * nwv.y); o.y = pk2(bflo(yr.y) * rstd * nwv.z, bfhi(yr.y) * rstd * nwv.w);
                *(u32x2*)(ymix + (size_t)(rowbase + srow) * MIX + 1024 + g * 512 + q * 16 + quad * 4) = o;
            }
            __syncthreads();
        }
        for (int item = bid; item < 256; item += G) {
            const int g = item & 1, sb = item >> 1, h = g * 8 + wave;
            const float dt = softplusf(dtraw[(size_t)(NP + sb) * 16 + h] + dt_bias[h]); const float dA = __expf(dt * -__expf(a_log[h]));
            const float* sx = sxbc + (size_t)sb * XBC;
            const int n4 = lane & 31, ph = lane >> 5;
            const f32x4 Bv = *(const f32x4*)(sx + 1024 + g * 128 + 4 * n4), Cv = *(const f32x4*)(sx + 1280 + g * 128 + 4 * n4);
            const float* sp = state_ssm + ((size_t)(sb * 16 + h) * 64) * 128 + 4 * n4; float* op = dout + O_NSS + ((size_t)(sb * 16 + h) * 64) * 128 + 4 * n4;
            float ymine = 0.f;
#pragma unroll 8
            for (int i = 0; i < 32; ++i) {
                const int p = i + 32 * ph; const float xv = sx[h * 64 + p] * dt;
                const f32x4 S = *(const f32x4*)(sp + (size_t)p * 128); const f32x4 Sn = S * dA + Bv * xv;
                *(f32x4*)(op + (size_t)p * 128) = Sn;
                float part = (Cv.x * Sn.x + Cv.y * Sn.y) + (Cv.z * Sn.z + Cv.w * Sn.w);
                part += __shfl_xor(part, 1); part += __shfl_xor(part, 2); part += __shfl_xor(part, 4); part += __shfl_xor(part, 8); part += __shfl_xor(part, 16);
                if ((lane & 31) == i) ymine = part;
            }
            const float xme = sx[h * 64 + lane];
            const float zz = bflo((unsigned)zB[(size_t)(NP + sb) * 1024 + h * 64 + lane]);
            const float y = (ymine + d_skip[h] * xme) * siluf(zz);
            const float s2 = wave_sum(y * y);
            if (lane == 0) red[wave] = s2;
            __syncthreads();
            float tot = 0.f;
#pragma unroll
            for (int q = 0; q < 8; ++q) tot += red[q];
            const float rstd = 1.0f / sqrtf(tot * (1.f / 512.f) + RMS_EPS);
            ymix[(size_t)(NP + sb) * MIX + 1024 + g * 512 + wave * 64 + lane] = (bf16_t)f2bf(y * rstd * ssm_norm_w[g * 512 + wave * 64 + lane]);
            __syncthreads();
        }
    }
    SEAM(7);
    if (IN(8)) { CArgs A_ = AP();
        pg8::Gemm g{ymix, WoutT, NP, DM, MIX}; pg8::StaticOrder S; S.init(NP, DM, G, bid);
        pg8::EpiRes E{x_prompt, pre1, mod + 2048, ALPHA};
        pg8::gemm_phase<pg8::EpiRes, pg8::StaticOrder, true, true>(L, g, S, E);
        __syncthreads();
        EpiResS ES{x_sample, pre1 + (size_t)NP * DM, mod + 8 * 6144 + 2048};
        small_gemm<4>((LAS float*)L, ymix + (size_t)NP * MIX, MIX, WoutT, MIX, 8, 8 * 64, MIX, ES, bid, G);
    }
    SEAM(8);
    if (IN(9)) { CArgs A_ = AP();
        for (int r = gw; r < NR; r += NGW) {
            f32x4 v[4]; ln_row(pre1 + (size_t)r * DM, ln1_g, ln1_b, lane, v);
            const float* mrow = mod + (size_t)(r < NP ? (r >> 11) : 8 + r - NP) * 6144;
#pragma unroll
            for (int j = 0; j < 4; ++j) { *((f32x4*)(Yf + (size_t)r * DM) + lane + 64 * j) = v[j];
                const f32x4 sh = *((const f32x4*)(mrow + 3072) + lane + 64 * j), sc = *((const f32x4*)(mrow + 4096) + lane + 64 * j);
                const f32x4 u = v[j] * (sc + 1.0f) + sh; u32x2 w; w.x = pk2(u.x, u.y); w.y = pk2(u.z, u.w); *((u32x2*)(vbf + (size_t)r * DM) + lane + 64 * j) = w; }
        }
    }
    SEAM(9);
    if (IN(10)) { CArgs A_ = AP();
        pg8::Gemm g{vbf, WupT, NP, DFF, DM}; pg8::StaticOrder S; S.init(NP, DFF, G, bid);
        pg8::EpiHid E{hid, DFF};
        pg8::gemm_phase<pg8::EpiHid, pg8::StaticOrder, true, true>(L, g, S, E);
        __syncthreads();
        EpiHidS ES{hid};
        small_gemm<1>((LAS float*)L, vbf + (size_t)NP * DM, DM, WupT, DM, 8, 8 * 256, 1024, ES, bid, G);
    }
    SEAM(10);
    if (IN(11)) { CArgs A_ = AP();
        pg8::Gemm g{hid, WdownT, NP, DM, DFF}; pg8::StaticOrder S; S.init(NP, DM, G, bid);
        pg8::EpiRes E{Yf, Yf, mod + 5120, ALPHA};
        pg8::gemm_phase<pg8::EpiRes, pg8::StaticOrder, true, true>(L, g, S, E);
        __syncthreads();
        EpiResS ES{Yf + (size_t)NP * DM, Yf + (size_t)NP * DM, mod + 8 * 6144 + 5120};
        small_gemm<4>((LAS float*)L, hid + (size_t)NP * DFF, DFF, WdownT, DFF, 8, 8 * 64, DFF, ES, bid, G);
    }
    SEAM(11);
    if (IN(12)) { CArgs A_ = AP();
        for (int r = gw; r < NR; r += NGW) {
            f32x4 v[4]; ln_row(Yf + (size_t)r * DM, ln2_g, ln2_b, lane, v);
#pragma unroll
            for (int j = 0; j < 4; ++j) *((f32x4*)(Yf + (size_t)r * DM) + lane + 64 * j) = v[j];
        }
    }
#undef IN
#undef SEAM
}
#undef dout
#undef x_prompt
#undef x_sample
#undef state_conv
#undef state_ssm_conv
#undef state_ssm
#undef c_prompt
#undef c_sample
#undef w_ada
#undef b_ada
#undef w_in
#undef conv_w
#undef conv_norm_w
#undef ssm_conv_w
#undef ssm_conv_b
#undef dt_bias
#undef a_log
#undef d_skip
#undef ssm_norm_w
#undef w_out
#undef ln1_g
#undef ln1_b
#undef w_up
#undef w_down
#undef ln2_g
#undef ln2_b
#undef WadaT
#undef WinT
#undef WoutT
#undef WupT
#undef WdownT
#undef cbf
#undef mod
#undef dtraw
#undef sxbc
#undef cdec
#undef ubf
#undef xT
#undef vbf
#undef gbB
#undef CS
#undef pre1
#undef hid
#undef hvB
#undef xbcB
#undef Sprev
#undef zB
#undef BC
#undef BT
#undef gcB
#undef ymix
#undef Yf

#ifndef MK_N_LAUNCHES
#define MK_N_LAUNCHES 1
#endif
constexpr int N_PHASES = 13;
extern "C" void kernel_launch(void* const* d_in, const int* in_sizes, int n_in, void* d_out, int out_size, void* d_ws, size_t ws_size, hipStream_t stream) {
    static int grid = 0;
    if (grid == 0) {
        int dev = 0, cus = 0, per_cu = 0;
        hipGetDevice(&dev);
        hipDeviceGetAttribute(&cus, hipDeviceAttributeMultiprocessorCount, dev);
        if (hipFuncSetAttribute((const void*)mk_fwd, hipFuncAttributeMaxDynamicSharedMemorySize, LDS_BYTES) != hipSuccess) { fprintf(stderr, "kernel_launch: hipFuncSetAttribute failed\n"); }
        if (hipOccupancyMaxActiveBlocksPerMultiprocessor(&per_cu, (const void*)mk_fwd, NTHREADS, LDS_BYTES) != hipSuccess || per_cu < 1) { fprintf(stderr, "kernel_launch: occupancy query says %d\n", per_cu); per_cu = 1; }
        (void)hipGetLastError();
        grid = cus * (per_cu > 1 ? 1 : per_cu);
        if (grid > 256) grid = 256;
    }
    Args a{};
    for (int i = 0; i < 25; ++i) a.in[i] = (const float*)d_in[i];
    a.out = (float*)d_out; a.ws = (unsigned char*)d_ws;
    if (MK_N_LAUNCHES == 1) {
        a.ph_lo = 0; a.ph_hi = N_PHASES;
        void* kargs[] = {&a};
        hipError_t e = hipLaunchCooperativeKernel((const void*)mk_fwd, dim3(grid), dim3(NTHREADS), kargs, LDS_BYTES, stream);
        if (e != hipSuccess) fprintf(stderr, "cooperative launch failed: %s (grid %d)\n", hipGetErrorString(e), grid);
    } else {
        for (int p = 0; p < N_PHASES; ++p) { a.ph_lo = p; a.ph_hi = p + 1; hipLaunchKernelGGL(mk_fwd, dim3(grid), dim3(NTHREADS), LDS_BYTES, stream, a); }
    }
}
```

```cpp
#include <hip/hip_runtime.h>
#include <hip/hip_cooperative_groups.h>
#include <cstdio>
#include <cstdint>
namespace cg = cooperative_groups;
namespace pg8 {
#define PG8_LAS __attribute__((address_space(3)))
typedef unsigned short bf16_t;
typedef short bf16x8 __attribute__((ext_vector_type(8)));
typedef float f32x4 __attribute__((ext_vector_type(4)));
typedef unsigned u32x4 __attribute__((ext_vector_type(4)));
constexpr int BM = 256, BK = 64, HALF = 128, HTB = HALF * BK * 2  , STAGE_BYTES = 8 * HTB, NXCD = 8, WGM = 8;

__host__ __device__ __forceinline__ int lds_byte(int r, int c) { const int st = (r >> 4) * 2 + (c >> 5), rr = r & 15, cc = c & 31, ob = rr * 64 + cc * 2; return st * 1024 + (ob ^ (((ob >> 9) & 1) << 5)); }
__host__ __device__ __forceinline__ void stage_rc(int b, int& R, int& C) { const int st = b / 1024, sb = b % 1024, swz = sb ^ (((sb >> 9) & 1) << 5); R = (st >> 1) * 16 + swz / 64; C = (st & 1) * 32 + (swz % 64) / 2; }
__host__ __device__ __forceinline__ int perm32(int rho) { const int n = rho >> 4, i = rho & 15; return 8 * (i >> 2) + 4 * n + (i & 3); }

struct Unit { int pm, pn; };
struct Gemm { const bf16_t* A; const bf16_t* Bt; int M, N, K; };

struct StaticOrder {
    int nM, nN, nwg, G, c;
    __host__ __device__ void init(int M, int N, int G_, int c_) { nM = M / BM; nN = N / BM; nwg = nM * nN; G = G_; c = c_; }
    __host__ __device__ bool next(int i, Unit& u) const {
        const long L = (long)i * G + c; if (L >= nwg) return false;
        int wgid = (int)L; { const int q = nwg / NXCD, r = nwg % NXCD, xcd = wgid % NXCD, off = wgid / NXCD; wgid = (xcd < r ? xcd * (q + 1) : r * (q + 1) + (xcd - r) * q) + off; }
        const int nig = WGM * nN, gid = wgid / nig, fm = gid * WGM, gsz = (nM - fm) < WGM ? (nM - fm) : WGM;
        u.pm = fm + ((wgid % nig) % gsz); u.pn = (wgid % nig) / gsz; return true;
    }
    __device__ __forceinline__ void a_ready(const Unit&) const {}
    __device__ __forceinline__ void done(const Unit&) const {}
};

__device__ __forceinline__ unsigned cvt_pk_bf16(float lo, float hi) { unsigned r; asm volatile("v_cvt_pk_bf16_f32 %0, %1, %2" : "=v"(r) : "v"(lo), "v"(hi)); return r; }
typedef float f32x2 __attribute__((ext_vector_type(2)));
typedef unsigned u32x2 __attribute__((ext_vector_type(2)));
struct EpiProj {
    static constexpr bool PERM = true, AFTER_DRAIN = false;
    bf16_t *gb, *gc, *hv, *z, *xbc;
    __device__ __forceinline__ void operator()(const f32x4 (&acc)[2][2][4][2], const Unit& u, int wr, int wc, int fr, int fq) const {
        const int colt = u.pn * BM; bf16_t* base; int ldc;
        if (colt < 1024) { base = gb + colt; ldc = 1024; }
        else if (colt < 2048) { base = gc + (colt - 1024); ldc = 1024; }
        else if (colt < 3072) { base = hv + (colt - 2048); ldc = 1024; }
        else if (colt < 4096) { base = z + (colt - 3072); ldc = 1024; }
        else { base = xbc + (colt - 4096); ldc = 1536; }
        const int row0 = u.pm * BM + wr * 64 + fr, col0 = wc * 32 + 8 * fq;
#pragma unroll
        for (int ai = 0; ai < 2; ++ai)
#pragma unroll
            for (int m = 0; m < 4; ++m) { bf16_t* rowp = base + (size_t)(row0 + ai * HALF + m * 16) * ldc + col0;
#pragma unroll
                for (int bj = 0; bj < 2; ++bj) { const f32x4 v0 = acc[ai][bj][m][0], v1 = acc[ai][bj][m][1];
                    u32x4 w; w.x = cvt_pk_bf16(v0[0], v0[1]); w.y = cvt_pk_bf16(v0[2], v0[3]); w.z = cvt_pk_bf16(v1[0], v1[1]); w.w = cvt_pk_bf16(v1[2], v1[3]);
                    *(u32x4*)(rowp + bj * HALF) = w; } }
    }
};
struct EpiHid {
    static constexpr bool PERM = true, AFTER_DRAIN = false;
    bf16_t* O; int ldc;
    __device__ __forceinline__ void operator()(const f32x4 (&acc)[2][2][4][2], const Unit& u, int wr, int wc, int fr, int fq) const {
        const int row0 = u.pm * BM + wr * 64 + fr, col0 = u.pn * BM + wc * 32 + 8 * fq;
#pragma unroll
        for (int ai = 0; ai < 2; ++ai)
#pragma unroll
            for (int m = 0; m < 4; ++m) { bf16_t* rowp = O + (size_t)(row0 + ai * HALF + m * 16) * ldc + col0;
#pragma unroll
                for (int bj = 0; bj < 2; ++bj) { f32x4 v0 = acc[ai][bj][m][0], v1 = acc[ai][bj][m][1];
#pragma unroll
                    for (int e = 0; e < 4; ++e) { float a = fmaxf(v0[e], 0.f), b = fmaxf(v1[e], 0.f); v0[e] = a * a; v1[e] = b * b; }
                    u32x4 w; w.x = cvt_pk_bf16(v0[0], v0[1]); w.y = cvt_pk_bf16(v0[2], v0[3]); w.z = cvt_pk_bf16(v1[0], v1[1]); w.w = cvt_pk_bf16(v1[2], v1[3]);
                    *(u32x4*)(rowp + bj * HALF) = w; } }
    }
};
struct EpiRes {
    static constexpr bool PERM = false, AFTER_DRAIN = false;
    const float* base; float* out; const float* gate  ; float alpha;
    __device__ __forceinline__ void operator()(const f32x4 (&acc)[2][2][4][2], const Unit& u, int wr, int wc, int fr, int fq) const {
        const int b = (u.pm * BM) >> 11; const float* gp = gate + (size_t)b * 6144;
        const int col0 = u.pn * BM + wc * 32 + 4 * fq;
        f32x4 gv[2][2];
#pragma unroll
        for (int bj = 0; bj < 2; ++bj)
#pragma unroll
            for (int n = 0; n < 2; ++n) { gv[bj][n] = *(const f32x4*)(gp + col0 + bj * HALF + n * 16); gv[bj][n] = gv[bj][n] + 1.0f; }
#pragma unroll
        for (int ai = 0; ai < 2; ++ai)
#pragma unroll
            for (int m = 0; m < 4; ++m) { const size_t off = (size_t)(u.pm * BM + ai * HALF + wr * 64 + m * 16 + fr) * 1024 + col0;
#pragma unroll
                for (int bj = 0; bj < 2; ++bj)
#pragma unroll
                    for (int n = 0; n < 2; ++n) { const f32x4 bs = *(const f32x4*)(base + off + bj * HALF + n * 16);
                        *(f32x4*)(out + off + bj * HALF + n * 16) = bs * alpha + gv[bj][n] * acc[ai][bj][m][n]; } }
    }
};

template <class Epi, class Sched, bool ALIGN_EPI = false, bool SP2 = false>
__device__ __forceinline__ void gemm_phase(PG8_LAS unsigned char* lds, const Gemm g, const Sched& S, const Epi& E) {
    const int tid = threadIdx.x, wid = __builtin_amdgcn_readfirstlane(tid >> 6), lane = tid & 63, wr = wid >> 2, wc = wid & 3, fr = lane & 15, fq = lane >> 4;
    const int K = g.K, nt = K / BK;
    unsigned voffA[2], voffB[2];
#pragma unroll
    for (int i = 0; i < 2; ++i) { int R, C; stage_rc(tid * 16 + i * 8192, R, C); const int Rb = Epi::PERM ? ((R & ~31) + perm32(R & 31)) : R;
        voffA[i] = (unsigned)(R * K + C) * 2u; voffB[i] = (unsigned)(Rb * K + C) * 2u; }
    const size_t kstep = (size_t)(BK * 2);
    const size_t hstep = (size_t)HALF * K * 2;
    const size_t tstep = 2 * hstep;
    const unsigned ldsw = (unsigned)wid * 1024u;
    const int aoff = lds_byte(wr * 64 + fr, fq * 8), boff = lds_byte(wc * 32 + fr, fq * 8);
#define PG8_SA(b, h) (((b) * 2 + (h)) * HTB)
#define PG8_SB(b, h) ((4 + (b) * 2 + (h)) * HTB)
#define PG8_STAGE(bufoff, gbase, voff) do { _Pragma("unroll") for (int _i = 0; _i < 2; ++_i) \
        __builtin_amdgcn_global_load_lds((const unsigned*)((const char*)(gbase) + (voff)[_i]), (PG8_LAS unsigned*)(lds + (bufoff) + ldsw + _i * 8192), 16, 0, 0); } while (0)
#define PG8_LDA(dst, b, h) do { _Pragma("unroll") for (int m = 0; m < 4; ++m) _Pragma("unroll") for (int k = 0; k < 2; ++k) dst[m][k] = *(const PG8_LAS bf16x8*)(lds + PG8_SA(b, h) + aoff + m * 2048 + k * 1024); } while (0)
#define PG8_LDB(dst, b, h) do { _Pragma("unroll") for (int n = 0; n < 2; ++n) _Pragma("unroll") for (int k = 0; k < 2; ++k) dst[n][k] = *(const PG8_LAS bf16x8*)(lds + PG8_SB(b, h) + boff + n * 2048 + k * 1024); } while (0)
#define PG8_MMA(ai, bj, At, Bt) do { __builtin_amdgcn_s_setprio(1); _Pragma("unroll") for (int m = 0; m < 4; ++m) _Pragma("unroll") for (int n = 0; n < 2; ++n) _Pragma("unroll") for (int k = 0; k < 2; ++k) \
        acc[ai][bj][m][n] = __builtin_amdgcn_mfma_f32_16x16x32_bf16(Bt[n][k], At[m][k], acc[ai][bj][m][n], 0, 0, 0); __builtin_amdgcn_s_setprio(0); } while (0)
#define PG8_WAIT_V(n) asm volatile("s_waitcnt vmcnt(" #n ")" ::: "memory")
#define PG8_WAIT_L(n) asm volatile("s_waitcnt lgkmcnt(" #n ")" ::: "memory")
#define PG8_BAR __builtin_amdgcn_s_barrier()
#define PG8_SCHED __builtin_amdgcn_sched_barrier(0)
    Unit cur, nxt; int ui = 0;
    if (!S.next(0, cur)) return;
    f32x4 acc[2][2][4][2];
#pragma unroll
    for (int a = 0; a < 2; ++a)
#pragma unroll
        for (int b = 0; b < 2; ++b)
#pragma unroll
            for (int m = 0; m < 4; ++m)
#pragma unroll
                for (int n = 0; n < 2; ++n) acc[a][b][m][n] = (f32x4){0.f, 0.f, 0.f, 0.f};
    bf16x8 At[4][2], B0[2][2], B1[2][2];
    const char* cA = (const char*)g.A + (size_t)cur.pm * tstep; const char* cB = (const char*)g.Bt + (size_t)cur.pn * tstep;
    S.a_ready(cur);
    if constexpr (SP2) {
        PG8_STAGE(PG8_SB(0, 0), cB, voffB); PG8_STAGE(PG8_SB(0, 1), cB + hstep, voffB); PG8_STAGE(PG8_SA(0, 0), cA, voffA); PG8_STAGE(PG8_SA(0, 1), cA + hstep, voffA);
        if (wr == 1) PG8_BAR;
        PG8_WAIT_V(2); PG8_BAR;
        PG8_STAGE(PG8_SB(1, 0), cB + kstep, voffB); PG8_STAGE(PG8_SA(1, 0), cA + kstep, voffA); PG8_STAGE(PG8_SB(1, 1), cB + hstep + kstep, voffB);
        PG8_WAIT_V(6); PG8_BAR;
    } else {
        PG8_STAGE(PG8_SB(0, 0), cB, voffB); PG8_STAGE(PG8_SA(0, 0), cA, voffA); PG8_STAGE(PG8_SB(0, 1), cB + hstep, voffB); PG8_STAGE(PG8_SA(0, 1), cA + hstep, voffA);
        if (wr == 1) PG8_BAR;
        PG8_WAIT_V(4); PG8_BAR;
        PG8_STAGE(PG8_SB(1, 0), cB + kstep, voffB); PG8_STAGE(PG8_SA(1, 0), cA + kstep, voffA); PG8_STAGE(PG8_SB(1, 1), cB + hstep + kstep, voffB);
        PG8_WAIT_V(6); PG8_BAR;
    }
    for (;;) {
        const bool has_next = S.next(ui + 1, nxt);
        const char* nA = has_next ? (const char*)g.A + (size_t)nxt.pm * tstep : cA; const char* nB = has_next ? (const char*)g.Bt + (size_t)nxt.pn * tstep : cB;
        for (int t = 0; t < nt; t += 2) {
            const bool last = (t == nt - 2);
            const char* a1 = cA + (size_t)(t + 1) * kstep;
            const char* a2 = last ? nA : cA + (size_t)(t + 2) * kstep; const char* b2 = last ? nB : cB + (size_t)(t + 2) * kstep;
            const char* a3 = a2 + kstep; const char* b3 = b2 + kstep;
            if (last && has_next) S.a_ready(nxt);
            if constexpr (SP2) {
            PG8_LDB(B0, 0, 0); PG8_LDB(B1, 0, 1); PG8_SCHED; PG8_LDA(At, 0, 0); PG8_STAGE(PG8_SA(1, 1), a1 + hstep, voffA);
            PG8_WAIT_V(8); PG8_WAIT_L(0); PG8_BAR; PG8_MMA(0, 0, At, B0); PG8_MMA(0, 1, At, B1); PG8_BAR; PG8_SCHED;
            PG8_LDA(At, 0, 1); PG8_STAGE(PG8_SB(0, 0), b2, voffB); PG8_STAGE(PG8_SB(0, 1), b2 + hstep, voffB); PG8_STAGE(PG8_SA(0, 0), a2, voffA);
            PG8_WAIT_V(8); PG8_WAIT_L(0); PG8_BAR; PG8_MMA(1, 0, At, B0); PG8_MMA(1, 1, At, B1); PG8_BAR; PG8_SCHED;
            PG8_LDB(B0, 1, 0); PG8_LDB(B1, 1, 1); PG8_SCHED; PG8_LDA(At, 1, 0); PG8_STAGE(PG8_SA(0, 1), a2 + hstep, voffA);
            PG8_WAIT_V(8); PG8_WAIT_L(0); PG8_BAR; PG8_MMA(0, 0, At, B0); PG8_MMA(0, 1, At, B1); PG8_BAR; PG8_SCHED;
            PG8_LDA(At, 1, 1); PG8_STAGE(PG8_SB(1, 0), b3, voffB); PG8_STAGE(PG8_SB(1, 1), b3 + hstep, voffB); PG8_STAGE(PG8_SA(1, 0), a3, voffA);
            PG8_WAIT_V(8); PG8_WAIT_L(0); PG8_BAR; PG8_MMA(1, 0, At, B0); PG8_MMA(1, 1, At, B1); PG8_BAR; PG8_SCHED;
            } else {
            PG8_LDB(B0, 0, 0); PG8_SCHED; PG8_LDA(At, 0, 0); PG8_STAGE(PG8_SA(1, 1), a1 + hstep, voffA);
            PG8_WAIT_L(8); PG8_BAR; PG8_WAIT_L(0); PG8_MMA(0, 0, At, B0); PG8_BAR; PG8_SCHED;
            PG8_LDB(B1, 0, 1); PG8_STAGE(PG8_SB(0, 0), b2, voffB);
            PG8_BAR; PG8_WAIT_L(0); PG8_MMA(0, 1, At, B1); PG8_BAR;
            PG8_LDA(At, 0, 1); PG8_STAGE(PG8_SA(0, 0), a2, voffA);
            PG8_BAR; PG8_WAIT_L(0); PG8_MMA(1, 0, At, B0); PG8_BAR; PG8_SCHED;
            PG8_STAGE(PG8_SB(0, 1), b2 + hstep, voffB);
            PG8_WAIT_V(6); PG8_BAR; PG8_MMA(1, 1, At, B1); PG8_BAR;
            PG8_LDB(B0, 1, 0); PG8_SCHED; PG8_LDA(At, 1, 0); PG8_STAGE(PG8_SA(0, 1), a2 + hstep, voffA);
            PG8_WAIT_L(8); PG8_BAR; PG8_WAIT_L(0); PG8_MMA(0, 0, At, B0); PG8_BAR; PG8_SCHED;
            PG8_LDB(B1, 1, 1); PG8_STAGE(PG8_SB(1, 0), b3, voffB);
            PG8_BAR; PG8_WAIT_L(0); PG8_MMA(0, 1, At, B1); PG8_BAR;
            PG8_LDA(At, 1, 1); PG8_STAGE(PG8_SA(1, 0), a3, voffA);
            PG8_BAR; PG8_WAIT_L(0); PG8_MMA(1, 0, At, B0); PG8_BAR; PG8_SCHED;
            PG8_STAGE(PG8_SB(1, 1), b3 + hstep, voffB);
            PG8_WAIT_V(6); PG8_BAR; PG8_MMA(1, 1, At, B1); PG8_BAR;
            }
        }
        if constexpr (ALIGN_EPI) { if (wr == 0) PG8_BAR; }
        if constexpr (!Epi::AFTER_DRAIN) { E(acc, cur, wr, wc, fr, fq); S.done(cur); }
        if (!has_next) break;
#pragma unroll
        for (int a = 0; a < 2; ++a)
#pragma unroll
            for (int b = 0; b < 2; ++b)
#pragma unroll
                for (int m = 0; m < 4; ++m)
#pragma unroll
                    for (int n = 0; n < 2; ++n) acc[a][b][m][n] = (f32x4){0.f, 0.f, 0.f, 0.f};
        cur = nxt; cA = nA; cB = nB; ++ui;
        if constexpr (ALIGN_EPI) { if (wr == 1) PG8_BAR; }
    }
    PG8_WAIT_V(0);
    if constexpr (!ALIGN_EPI) { if (wr == 0) PG8_BAR; }
    PG8_BAR;
    if constexpr (Epi::AFTER_DRAIN) { E.fused(acc, cur, wr, wc, fr, fq, lds, wid, lane); S.done(cur); }
#undef PG8_SA
#undef PG8_SB
#undef PG8_STAGE
#undef PG8_LDA
#undef PG8_LDB
#undef PG8_MMA
#undef PG8_WAIT_V
#undef PG8_WAIT_L
#undef PG8_BAR
#undef PG8_SCHED
}
}

#define LAS __attribute__((address_space(3)))
typedef unsigned short bf16_t;
typedef short bf16x8 __attribute__((ext_vector_type(8)));
typedef short bf16x4 __attribute__((ext_vector_type(4)));
typedef float f32x4 __attribute__((ext_vector_type(4)));
typedef unsigned u32x4 __attribute__((ext_vector_type(4)));
typedef unsigned u32x2 __attribute__((ext_vector_type(2)));

constexpr int DM = 1024, NP = 16384, NSMP = 128, NR = NP + NSMP, NINW = 5648, NINM = 5632, XBC = 1536, DFF = 4096, MIX = 2048;
constexpr float ALPHA = 1.189207115002721f, LN_EPS = 1e-5f, RMS_EPS = 1e-5f;
constexpr int NWAVES = 8, NTHREADS = 512;
constexpr int LDS_BYTES = 147456;
constexpr size_t O_Y = 0, O_NCP = 16908288, O_NSCP = 16924672, O_NSP = 16961536, O_NCS = 18010112, O_NSCS = 18272256, O_NSS = 18862080;
constexpr size_t MiB = 1u << 20;
constexpr size_t WS_WADA = 1 * MiB, WS_BT = 1 * MiB, WS_WIN = 13 * MiB, WS_WOUT = 24 * MiB, WS_WUP = 28 * MiB, WS_WDOWN = 36 * MiB;
constexpr size_t WS_CBF = 44 * MiB, WS_MOD = 45 * MiB, WS_DTRAW = 49 * MiB, WS_SXBC = 50 * MiB + 512 * 1024, WS_CDEC = 51 * MiB + 512 * 1024;
constexpr size_t WS_S0 = 52 * MiB, WS_S1 = 85 * MiB, WS_S2 = 118 * MiB, WS_S3 = 151 * MiB, WS_S4 = 200 * MiB, WS_S5 = 233 * MiB;

struct Args {
    const float* in[25]; float* out; unsigned char* ws; int ph_lo, ph_hi;
};
typedef const __attribute__((address_space(4))) Args* CArgs;
#define AP() ({ CArgs _p = (CArgs)__builtin_amdgcn_kernarg_segment_ptr(); asm volatile("" : "+s"(_p)); _p; })

__device__ __forceinline__ unsigned f2bf(float f) { unsigned u = __builtin_bit_cast(unsigned, f); return (u + 0x7fffu + ((u >> 16) & 1u)) >> 16; }
__device__ __forceinline__ unsigned pk2(float lo, float hi) { return pg8::cvt_pk_bf16(lo, hi); }
__device__ __forceinline__ float bflo(unsigned u) { return __builtin_bit_cast(float, u << 16); }
__device__ __forceinline__ float bfhi(unsigned u) { return __builtin_bit_cast(float, u & 0xffff0000u); }
__device__ __forceinline__ void unpack8(const u32x4 v, float* f) { f[0] = bflo(v.x); f[1] = bfhi(v.x); f[2] = bflo(v.y); f[3] = bfhi(v.y); f[4] = bflo(v.z); f[5] = bfhi(v.z); f[6] = bflo(v.w); f[7] = bfhi(v.w); }
__device__ __forceinline__ float wave_sum(float v) {
#pragma unroll
    for (int o = 1; o < 64; o <<= 1) v += __shfl_xor(v, o);
    return v;
}
__device__ __forceinline__ float siluf(float x) { return x / (1.0f + __expf(-x)); }
__device__ __forceinline__ float softplusf(float x) { return x > 20.f ? x : log1pf(__expf(x)); }
#define LDS_FENCE() asm volatile("s_waitcnt lgkmcnt(0)" ::: "memory")

__device__ __forceinline__ void transpose_item(const float* W, int ldw, int nblk, int K, bf16_t* WT, LAS float* scr, int item, int lane) {
    const int kb = item / nblk, nb = item % nblk, k0 = 64 * kb, n0 = 32 * nb;
#pragma unroll 8
    for (int i = 0; i < 32; ++i) { const int kk = 2 * i + (lane >> 5); scr[kk * 33 + (lane & 31)] = W[(size_t)(k0 + kk) * ldw + n0 + (lane & 31)]; }
    LDS_FENCE();
    const int c = lane & 7;
#pragma unroll
    for (int j = 0; j < 4; ++j) { const int n = (lane >> 3) + 8 * j; const LAS float* s = scr + (8 * c) * 33 + n;
        u32x4 o; o.x = pk2(s[0 * 33], s[1 * 33]); o.y = pk2(s[2 * 33], s[3 * 33]); o.z = pk2(s[4 * 33], s[5 * 33]); o.w = pk2(s[6 * 33], s[7 * 33]);
        *(u32x4*)(WT + (size_t)(n0 + n) * K + k0 + 8 * c) = o; }
    LDS_FENCE();
}

template <int KS, class Epi>
__device__ __forceinline__ void small_gemm(LAS float* red, const bf16_t* A, int lda, const bf16_t* Bt, int ldb, int Mtiles, int ntiles_total, int K, const Epi& epi, int it0, int itstride) {
    const int tid = threadIdx.x, wave = __builtin_amdgcn_readfirstlane(tid >> 6), lane = tid & 63, r16 = lane & 15, quad = lane >> 4;
    constexpr int TPW = 8 / KS;
    const int sub = wave / KS, ks = wave % KS, kchunk = K / KS;
    const int niter = (ntiles_total + TPW - 1) / TPW;
    for (int it = it0; it < niter; it += itstride) {
        const int tile = it * TPW + sub; const bool valid = tile < ntiles_total;
        f32x4 acc = {0.f, 0.f, 0.f, 0.f}; int mt = 0, nt = 0;
        if (valid) {
            mt = tile % Mtiles; nt = tile / Mtiles;
            const bf16_t* ap = A + (size_t)(mt * 16 + r16) * lda + ks * kchunk + quad * 8;
            const bf16_t* bp = Bt + (size_t)(nt * 16 + r16) * ldb + ks * kchunk + quad * 8;
            for (int k = 0; k < kchunk; k += 256) {
                bf16x8 a[8], b[8];
#pragma unroll
                for (int j = 0; j < 8; ++j) { a[j] = *(const bf16x8*)(ap + k + j * 32); b[j] = *(const bf16x8*)(bp + k + j * 32); }
#pragma unroll
                for (int j = 0; j < 8; ++j) acc = __builtin_amdgcn_mfma_f32_16x16x32_bf16(b[j], a[j], acc, 0, 0, 0);
            }
        }
        if constexpr (KS > 1) {
            *(LAS f32x4*)(red + (wave * 64 + lane) * 4) = acc;
            __syncthreads();
            if (ks == 0) {
#pragma unroll
                for (int q = 1; q < KS; ++q) acc += *(const LAS f32x4*)(red + ((wave + q) * 64 + lane) * 4);
            }
            __syncthreads();
        }
        if (valid && ks == 0) epi(mt * 16 + r16, nt * 16 + quad * 4, acc);
    }
}
struct EpiMod { float* mod; const float* b_ada;
    __device__ __forceinline__ void operator()(int row, int col, f32x4 v) const { if (row < 136) *(f32x4*)(mod + (size_t)row * 6144 + col) = v + *(const f32x4*)(b_ada + col); } };
struct EpiProjS { bf16_t *gb, *gc, *hv, *z, *xbc;
    __device__ __forceinline__ void operator()(int row, int col, f32x4 v) const {
        bf16_t* base; int ldc; int c = col;
        if (c < 1024) { base = gb; ldc = 1024; } else if (c < 2048) { base = gc; c -= 1024; ldc = 1024; } else if (c < 3072) { base = hv; c -= 2048; ldc = 1024; }
        else if (c < 4096) { base = z; c -= 3072; ldc = 1024; } else { base = xbc; c -= 4096; ldc = 1536; }
        u32x2 w; w.x = pk2(v[0], v[1]); w.y = pk2(v[2], v[3]); *(u32x2*)(base + (size_t)(NP + row) * ldc + c) = w; } };
struct EpiHidS { bf16_t* O;
    __device__ __forceinline__ void operator()(int row, int col, f32x4 v) const {
#pragma unroll
        for (int e = 0; e < 4; ++e) { const float a = fmaxf(v[e], 0.f); v[e] = a * a; }
        u32x2 w; w.x = pk2(v[0], v[1]); w.y = pk2(v[2], v[3]); *(u32x2*)(O + (size_t)(NP + row) * DFF + col) = w; } };
struct EpiResS { const float* base  ; float* out; const float* gate  ;
    __device__ __forceinline__ void operator()(int row, int col, f32x4 v) const {
        const f32x4 g = *(const f32x4*)(gate + (size_t)row * 6144 + col) + 1.0f; const f32x4 bs = *(const f32x4*)(base + (size_t)row * 1024 + col);
        *(f32x4*)(out + (size_t)row * 1024 + col) = bs * ALPHA + g * v; } };

__device__ __forceinline__ void dt_scan(const float* dtraw, int rowbase, int h, float dtb, float a, int lane, float& dt0, float& dt1, float& acs0, float& acs1, float& total) {
    const float r0 = dtraw[(size_t)(rowbase + 2 * lane) * 16 + h] + dtb, r1 = dtraw[(size_t)(rowbase + 2 * lane + 1) * 16 + h] + dtb;
    dt0 = softplusf(r0); dt1 = softplusf(r1);
    const float d0 = dt0 * a, d1 = dt1 * a;
    float incl = d0 + d1;
#pragma unroll
    for (int o = 1; o < 64; o <<= 1) { const float t = __shfl_up(incl, o); if (lane >= o) incl += t; }
    const float excl = incl - (d0 + d1);
    acs0 = excl + d0; acs1 = excl + d0 + d1;
    total = __shfl(incl, 63);
}

__device__ __forceinline__ void ln_row(const float* xrow, const float* g, const float* bta, int lane, f32x4 (&v)[4]) {
    const f32x4* xr = (const f32x4*)xrow + lane; float s = 0.f;
#pragma unroll
    for (int j = 0; j < 4; ++j) { v[j] = xr[64 * j]; s += (v[j].x + v[j].y) + (v[j].z + v[j].w); }
    const float mean = wave_sum(s) * (1.f / DM); float s2 = 0.f;
#pragma unroll
    for (int j = 0; j < 4; ++j) { v[j] = v[j] - mean; s2 += (v[j].x * v[j].x + v[j].y * v[j].y) + (v[j].z * v[j].z + v[j].w * v[j].w); }
    const float rstd = 1.f / sqrtf(wave_sum(s2) * (1.f / DM) + LN_EPS);
#pragma unroll
    for (int j = 0; j < 4; ++j) { const f32x4 gg = *((const f32x4*)g + lane + 64 * j), bb = *((const f32x4*)bta + lane + 64 * j); v[j] = v[j] * rstd * gg + bb; }
}

#define XB_TMO      128
#define XB_XCNT(j)  (256  + 64 * (j))
#define XB_XSUB(j)  (1280 + 64 * (j))
#define XB_XGEN(j)  (2304 + 64 * (j))
#define XB_TOP      3328
#define XB_TOPGEN   3392
#define XCD_BAR_WORDS 3456
#define XB_SPIN_CAP (1u << 18)

__device__ __forceinline__ unsigned xb_ld(unsigned* p)              { return __hip_atomic_load(p, __ATOMIC_RELAXED, __HIP_MEMORY_SCOPE_AGENT); }
__device__ __forceinline__ unsigned xb_add(unsigned* p, unsigned v) { return __hip_atomic_fetch_add(p, v, __ATOMIC_RELAXED, __HIP_MEMORY_SCOPE_AGENT); }
__device__ __forceinline__ unsigned xb_xcc_id() { return (unsigned)__builtin_amdgcn_s_getreg((3 << 11) | 20) & 0xFu; }
#define XB_SPIN(cond, bar) do { unsigned _sp = 0; while (cond) { __builtin_amdgcn_s_sleep(1); \
    if ((++_sp & 255u) == 0u) { if (xb_ld(&(bar)[XB_TMO])) break; if (_sp > XB_SPIN_CAP) { atomicAdd(&(bar)[XB_TMO], 1u); break; } } } } while (0)

struct XcdBarrier {
    unsigned* bar; unsigned x;
    volatile LAS unsigned* st;
};

__device__ __forceinline__ XcdBarrier xcd_barrier_post(unsigned* bar, volatile LAS unsigned* st) {
    XcdBarrier b; b.bar = bar; b.x = xb_xcc_id(); b.st = st;
    if (threadIdx.x == 0) (void)xb_add(&bar[XB_XCNT(b.x)], 1u);
    return b;
}
__device__ __forceinline__ void xcd_barrier_complete(unsigned* bar, unsigned x, unsigned& nloc, unsigned& nx) {
    const unsigned G = gridDim.x * gridDim.y * gridDim.z;
    unsigned sum, cnt, mine, sp = 0u;
    for (;;) {
        sum = 0u; cnt = 0u; mine = 0u;
#pragma unroll
        for (unsigned j = 0; j < 16; ++j) { const unsigned c = xb_ld(&bar[XB_XCNT(j)]); sum += c; cnt += (c > 0u) ? 1u : 0u; mine = (j == x) ? c : mine; }
        if (sum == G) break;
        __builtin_amdgcn_s_sleep(1);
        if ((++sp & 255u) == 0u) { if (xb_ld(&bar[XB_TMO])) break; if (sp > XB_SPIN_CAP) { atomicAdd(&bar[XB_TMO], 1u); break; } }
    }
    nloc = mine > 0u ? mine : 1u; nx = cnt > 0u ? cnt : 1u;
}

__device__ __forceinline__ void xcd_barrier(const XcdBarrier& b) {
    asm volatile("s_waitcnt vmcnt(0)" ::: "memory");
    __syncthreads();
    if (threadIdx.x == 0) {
        unsigned* bar = b.bar;
        __builtin_amdgcn_s_waitcnt(0);
        unsigned nloc = b.st[0], nx = b.st[1];
        if (nloc == 0u) { xcd_barrier_complete(bar, b.x, nloc, nx); b.st[0] = nloc; b.st[1] = nx; }
        const unsigned old = xb_add(&bar[XB_XSUB(b.x)], 1u);
        const unsigned gen = old / nloc;
        if (old + 1u == (gen + 1u) * nloc) {
            __builtin_amdgcn_fence(__ATOMIC_RELEASE, "agent");
            asm volatile("s_waitcnt vmcnt(0)" ::: "memory");
            const unsigned og = xb_add(&bar[XB_TOP], 1u);
            const unsigned tg = og / nx;
            if (og + 1u == (tg + 1u) * nx) xb_add(&bar[XB_TOPGEN], 1u);
            else XB_SPIN(xb_ld(&bar[XB_TOPGEN]) == tg, bar);
            __builtin_amdgcn_fence(__ATOMIC_ACQUIRE, "agent");
            xb_add(&bar[XB_XGEN(b.x)], 1u);
            asm volatile("s_waitcnt vmcnt(0)" ::: "memory");
        } else {
            XB_SPIN(xb_ld(&bar[XB_XGEN(b.x)]) == gen, bar);
            __builtin_amdgcn_fence(__ATOMIC_ACQUIRE, "agent");
            asm volatile("s_waitcnt vmcnt(0)" ::: "memory");
        }
    }
    __syncthreads();
}

#ifndef MK_DUPMASK
#define MK_DUPMASK 0
#endif
#ifndef MK_SYNCREP
#define MK_SYNCREP 1
#endif
__global__ void __launch_bounds__(NTHREADS, 2) mk_fwd(Args args) {
    extern __shared__ __attribute__((aligned(16))) unsigned char lds[];
    LAS unsigned char* const L = (LAS unsigned char*)lds;
    const int tid = threadIdx.x, lane = tid & 63, wave = __builtin_amdgcn_readfirstlane(tid >> 6);
    const int G = gridDim.x, bid = blockIdx.x;
    const int gw = bid * NWAVES + wave, NGW = G * NWAVES;
#define dout (A_->out)
#define x_prompt (A_->in[0])
#define x_sample (A_->in[1])
#define state_conv (A_->in[2])
#define state_ssm_conv (A_->in[3])
#define state_ssm (A_->in[4])
#define c_prompt (A_->in[5])
#define c_sample (A_->in[6])
#define w_ada (A_->in[7])
#define b_ada (A_->in[8])
#define w_in (A_->in[9])
#define conv_w (A_->in[10])
#define conv_norm_w (A_->in[11])
#define ssm_conv_w (A_->in[12])
#define ssm_conv_b (A_->in[13])
#define dt_bias (A_->in[14])
#define a_log (A_->in[15])
#define d_skip (A_->in[16])
#define ssm_norm_w (A_->in[17])
#define w_out (A_->in[18])
#define ln1_g (A_->in[19])
#define ln1_b (A_->in[20])
#define w_up (A_->in[21])
#define w_down (A_->in[22])
#define ln2_g (A_->in[23])
#define ln2_b (A_->in[24])
#define WadaT ((bf16_t*)(A_->ws + WS_WADA))
#define WinT ((bf16_t*)(A_->ws + WS_WIN))
#define WoutT ((bf16_t*)(A_->ws + WS_WOUT))
#define WupT ((bf16_t*)(A_->ws + WS_WUP))
#define WdownT ((bf16_t*)(A_->ws + WS_WDOWN))
#define cbf ((bf16_t*)(A_->ws + WS_CBF))
#define mod ((float*)(A_->ws + WS_MOD))
#define dtraw ((float*)(A_->ws + WS_DTRAW))
#define sxbc ((float*)(A_->ws + WS_SXBC))
#define cdec ((float*)(A_->ws + WS_CDEC))
#define ubf ((bf16_t*)(A_->ws + WS_S0))
#define xT ((bf16_t*)(A_->ws + WS_S0))
#define vbf ((bf16_t*)(A_->ws + WS_S0))
#define gbB ((bf16_t*)(A_->ws + WS_S1))
#define CS ((float*)(A_->ws + WS_S1))
#define pre1 ((float*)(A_->ws + WS_S1))
#define hid ((bf16_t*)(A_->ws + WS_S1))
#define hvB ((bf16_t*)(A_->ws + WS_S2))
#define xbcB ((bf16_t*)(A_->ws + WS_S3))
#define Sprev ((bf16_t*)(A_->ws + WS_S3))
#define zB ((bf16_t*)(A_->ws + WS_S4))
#define BC ((bf16_t*)(A_->ws + WS_S5))
#define BT ((bf16_t*)(A_->ws + WS_BT))
#define gcB ((bf16_t*)(A_->out + O_NSS))
#define ymix ((bf16_t*)(A_->out + O_Y))
#define Yf (A_->out + O_Y)
    const int lo = args.ph_lo, hi = args.ph_hi;
    volatile LAS unsigned* MISC = (volatile LAS unsigned*)(L + 147200);
    if (tid < 16) MISC[tid] = 0u;
    __syncthreads();
    XcdBarrier bar; bar.bar = (unsigned*)args.ws + 1024; bar.x = 0; bar.st = MISC;
    if (hi - lo > 1) bar = xcd_barrier_post((unsigned*)args.ws + 1024, MISC);
#define IN(k) (lo <= (k) && (k) < hi)
#define SEAM(k) do { if (IN(k) && IN((k) + 1)) { for (int sr_ = 0; sr_ < MK_SYNCREP; ++sr_) xcd_barrier(bar); } } while (0)

    if (IN(0)) for (int rep_ = 0; rep_ < (((MK_DUPMASK >> 0) & 1) ? 2 : 1); ++rep_) { CArgs A_ = AP();
        LAS float* scr = (LAS float*)(L + wave * 16384);
        constexpr int I_ADA = 16 * 192, I_IN = 16 * 176, I_OUT = 32 * 32, I_UP = 16 * 128, I_DOWN = 64 * 32;
        constexpr int NITEMS = I_ADA + I_IN + I_OUT + I_UP + I_DOWN;
        for (int it = gw; it < NITEMS; it += NGW) {
            int r = it;
            if (r < I_ADA) { transpose_item(w_ada, 6144, 192, 1024, WadaT, scr, r, lane); continue; } r -= I_ADA;
            if (r < I_IN) { transpose_item(w_in, NINW, 176, 1024, WinT, scr, r, lane); continue; } r -= I_IN;
            if (r < I_OUT) { transpose_item(w_out, 1024, 32, 2048, WoutT, scr, r, lane); continue; } r -= I_OUT;
            if (r < I_UP) { transpose_item(w_up, 4096, 128, 1024, WupT, scr, r, lane); continue; } r -= I_UP;
            transpose_item(w_down, 1024, 32, 4096, WdownT, scr, r, lane);
        }
        for (int r = gw; r < 144; r += NGW) {
            const float* src = r < 8 ? c_prompt + (size_t)r * DM : c_sample + (size_t)(r - 8) * DM;
#pragma unroll
            for (int j = 0; j < 4; ++j) { f32x4 v = {0.f, 0.f, 0.f, 0.f}; if (r < 136) v = *((const f32x4*)src + lane + 64 * j);
                u32x2 w; w.x = pk2(v.x, v.y); w.y = pk2(v.z, v.w); *((u32x2*)(cbf + (size_t)r * DM) + lane + 64 * j) = w; }
        }
    }
    SEAM(0);
    if (IN(1)) for (int rep_ = 0; rep_ < (((MK_DUPMASK >> 1) & 1) ? 2 : 1); ++rep_) { CArgs A_ = AP();
        EpiMod E{mod, b_ada};
        small_gemm<1>((LAS float*)L, cbf, DM, WadaT, DM, 9, 9 * 384, 1024, E, bid, G);
    }
    SEAM(1);
    if (IN(2)) for (int rep_ = 0; rep_ < (((MK_DUPMASK >> 2) & 1) ? 2 : 1); ++rep_) { CArgs A_ = AP();
        LAS float* w16 = (LAS float*)L;
        for (int i = tid; i < 4096; i += NTHREADS) { const int k = i >> 2, c4 = i & 3; *(LAS f32x4*)(w16 + k * 20 + c4 * 4) = *(const f32x4*)(w_in + (size_t)k * NINW + NINM + c4 * 4); }
        __syncthreads();
        for (int r = gw; r < NR; r += NGW) {
            const float* xrow = r < NP ? x_prompt + (size_t)r * DM : x_sample + (size_t)(r - NP) * DM;
            const float* mrow = mod + (size_t)(r < NP ? (r >> 11) : 8 + r - NP) * 6144;
            float acc[16];
#pragma unroll
            for (int c = 0; c < 16; ++c) acc[c] = 0.f;
#pragma unroll
            for (int j = 0; j < 4; ++j) {
                const f32x4 xv = *((const f32x4*)xrow + lane + 64 * j), sh = *((const f32x4*)mrow + lane + 64 * j), sc = *((const f32x4*)(mrow + 1024) + lane + 64 * j);
                const f32x4 u = xv * (sc + 1.0f) + sh;
                u32x2 w; w.x = pk2(u.x, u.y); w.y = pk2(u.z, u.w); *((u32x2*)(ubf + (size_t)r * DM) + lane + 64 * j) = w;
#pragma unroll
                for (int e = 0; e < 4; ++e) { const int k = 256 * j + 4 * lane + e; const LAS f32x4* wp = (const LAS f32x4*)(w16 + k * 20);
#pragma unroll
                    for (int c4 = 0; c4 < 4; ++c4) { const f32x4 wv = wp[c4];
#pragma unroll
                        for (int q = 0; q < 4; ++q) acc[c4 * 4 + q] += u[e] * wv[q]; } }
            }
#pragma unroll
            for (int c = 0; c < 16; ++c) acc[c] = wave_sum(acc[c]);
            if (lane == 0) {
#pragma unroll
                for (int c4 = 0; c4 < 4; ++c4) *(f32x4*)(dtraw + (size_t)r * 16 + c4 * 4) = (f32x4){acc[c4 * 4], acc[c4 * 4 + 1], acc[c4 * 4 + 2], acc[c4 * 4 + 3]};
            }
        }
        __syncthreads();
    }
    SEAM(2);
    if (IN(3)) for (int rep_ = 0; rep_ < (((MK_DUPMASK >> 3) & 1) ? 2 : 1); ++rep_) { CArgs A_ = AP();
        pg8::Gemm g{ubf, WinT, NP, NINM, DM}; pg8::StaticOrder S; S.init(NP, NINM, G, bid);
        pg8::EpiProj E{gbB, gcB, hvB, zB, xbcB};
        pg8::gemm_phase<pg8::EpiProj, pg8::StaticOrder, true, true>(L, g, S, E);
        __syncthreads();
        EpiProjS ES{gbB, gcB, hvB, zB, xbcB};
        small_gemm<1>((LAS float*)L, ubf + (size_t)NP * DM, DM, WinT, DM, 8, 8 * 352, 1024, ES, (bid + 128) % G, G);
    }
    SEAM(3);
    if (IN(4)) for (int rep_ = 0; rep_ < (((MK_DUPMASK >> 4) & 1) ? 2 : 1); ++rep_) { CArgs A_ = AP();
        for (int T = gw; T < 2048 + 128; T += NGW) {
            const bool smp = T >= 2048; const int row0 = smp ? NP + (T - 2048) : T * 8, n = smp ? 1 : 8;
            const int b = row0 >> 11, t0 = row0 & 2047, c0 = 16 * lane;
            float cw[3][16], nw[16], p1[16], p2[16];
#pragma unroll
            for (int k = 0; k < 3; ++k)
#pragma unroll
                for (int q = 0; q < 4; ++q) { const f32x4 v = *(const f32x4*)(conv_w + k * 1024 + c0 + 4 * q); cw[k][4 * q] = v.x; cw[k][4 * q + 1] = v.y; cw[k][4 * q + 2] = v.z; cw[k][4 * q + 3] = v.w; }
#pragma unroll
            for (int q = 0; q < 4; ++q) { const f32x4 v = *(const f32x4*)(conv_norm_w + c0 + 4 * q); nw[4 * q] = v.x; nw[4 * q + 1] = v.y; nw[4 * q + 2] = v.z; nw[4 * q + 3] = v.w; }
            if (smp) {
                const float* st = state_conv + (size_t)(T - 2048) * 2048 + c0;
#pragma unroll
                for (int q = 0; q < 4; ++q) { const f32x4 a = *(const f32x4*)(st + 4 * q), bb = *(const f32x4*)(st + 1024 + 4 * q);
                    p2[4 * q] = a.x; p2[4 * q + 1] = a.y; p2[4 * q + 2] = a.z; p2[4 * q + 3] = a.w; p1[4 * q] = bb.x; p1[4 * q + 1] = bb.y; p1[4 * q + 2] = bb.z; p1[4 * q + 3] = bb.w; }
            } else if (t0 == 0) {
#pragma unroll
                for (int e = 0; e < 16; ++e) { p1[e] = 0.f; p2[e] = 0.f; }
            } else {
#pragma unroll
                for (int hh = 0; hh < 2; ++hh) {
                    float a[16], bb[16];
                    const size_t o2 = (size_t)(row0 - 2) * 1024 + c0 + 8 * hh, o1 = (size_t)(row0 - 1) * 1024 + c0 + 8 * hh;
                    unpack8(*(const u32x4*)(gcB + o2), a); unpack8(*(const u32x4*)(hvB + o2), a + 8);
                    unpack8(*(const u32x4*)(gcB + o1), bb); unpack8(*(const u32x4*)(hvB + o1), bb + 8);
#pragma unroll
                    for (int e = 0; e < 8; ++e) { p2[8 * hh + e] = a[e] * a[8 + e]; p1[8 * hh + e] = bb[e] * bb[8 + e]; }
                }
            }
            for (int i = 0; i < n; ++i) {
                const int row = row0 + i; float gv[16], cv[16], hv[16], ch[16], y[16];
                const size_t o = (size_t)row * 1024 + c0;
                unpack8(*(const u32x4*)(gbB + o), gv); unpack8(*(const u32x4*)(gbB + o + 8), gv + 8);
                unpack8(*(const u32x4*)(gcB + o), cv); unpack8(*(const u32x4*)(gcB + o + 8), cv + 8);
                unpack8(*(const u32x4*)(hvB + o), hv); unpack8(*(const u32x4*)(hvB + o + 8), hv + 8);
                float ss = 0.f;
#pragma unroll
                for (int e = 0; e < 16; ++e) { ch[e] = cv[e] * hv[e]; const float c3 = cw[0][e] * p2[e] + cw[1][e] * p1[e] + cw[2][e] * ch[e]; y[e] = gv[e] * c3; ss += y[e] * y[e]; }
                ss += __shfl_xor(ss, 1); ss += __shfl_xor(ss, 2);
                const float rstd = 1.0f / sqrtf(ss * (1.f / 64.f) + RMS_EPS);
                u32x4 w0, w1;
                w0.x = pk2(y[0] * rstd * nw[0], y[1] * rstd * nw[1]); w0.y = pk2(y[2] * rstd * nw[2], y[3] * rstd * nw[3]); w0.z = pk2(y[4] * rstd * nw[4], y[5] * rstd * nw[5]); w0.w = pk2(y[6] * rstd * nw[6], y[7] * rstd * nw[7]);
                w1.x = pk2(y[8] * rstd * nw[8], y[9] * rstd * nw[9]); w1.y = pk2(y[10] * rstd * nw[10], y[11] * rstd * nw[11]); w1.z = pk2(y[12] * rstd * nw[12], y[13] * rstd * nw[13]); w1.w = pk2(y[14] * rstd * nw[14], y[15] * rstd * nw[15]);
                *(u32x4*)(ymix + (size_t)row * MIX + c0) = w0; *(u32x4*)(ymix + (size_t)row * MIX + c0 + 8) = w1;
                if (smp) {
                    float* o0 = dout + O_NCS + (size_t)(T - 2048) * 2048 + c0;
#pragma unroll
                    for (int q = 0; q < 4; ++q) { *(f32x4*)(o0 + 4 * q) = (f32x4){p1[4 * q], p1[4 * q + 1], p1[4 * q + 2], p1[4 * q + 3]}; *(f32x4*)(o0 + 1024 + 4 * q) = (f32x4){ch[4 * q], ch[4 * q + 1], ch[4 * q + 2], ch[4 * q + 3]}; }
                } else if (t0 + i >= 2046) {
                    float* o0 = dout + O_NCP + (size_t)(b * 2 + (t0 + i - 2046)) * 1024 + c0;
#pragma unroll
                    for (int q = 0; q < 4; ++q) *(f32x4*)(o0 + 4 * q) = (f32x4){ch[4 * q], ch[4 * q + 1], ch[4 * q + 2], ch[4 * q + 3]};
                }
#pragma unroll
                for (int e = 0; e < 16; ++e) { p2[e] = p1[e]; p1[e] = ch[e]; }
            }
        }
        for (int T = gw; T < 3 * (2048 + 128); T += NGW) {
            const int j = T % 3, strip = T / 3; const bool smp = strip >= 2048;
            const int row0 = smp ? NP + (strip - 2048) : strip * 8;
            const int b = row0 >> 11, t0 = row0 & 2047, c0 = j * 512 + 8 * lane;
            float w[4][8], bias[8], q1[8], q2[8], q3[8];
#pragma unroll
            for (int k = 0; k < 4; ++k) { const f32x4 a = *(const f32x4*)(ssm_conv_w + k * XBC + c0), bb = *(const f32x4*)(ssm_conv_w + k * XBC + c0 + 4);
                w[k][0] = a.x; w[k][1] = a.y; w[k][2] = a.z; w[k][3] = a.w; w[k][4] = bb.x; w[k][5] = bb.y; w[k][6] = bb.z; w[k][7] = bb.w; }
            { const f32x4 a = *(const f32x4*)(ssm_conv_b + c0), bb = *(const f32x4*)(ssm_conv_b + c0 + 4);
              bias[0] = a.x; bias[1] = a.y; bias[2] = a.z; bias[3] = a.w; bias[4] = bb.x; bias[5] = bb.y; bias[6] = bb.z; bias[7] = bb.w; }
            if (smp) {
                const int sb = strip - 2048; const float* st = state_ssm_conv + (size_t)sb * 3 * XBC + c0;
#pragma unroll
                for (int e = 0; e < 8; ++e) { q3[e] = st[e]; q2[e] = st[XBC + e]; q1[e] = st[2 * XBC + e]; }
                float cur[8]; unpack8(*(const u32x4*)(xbcB + (size_t)row0 * XBC + c0), cur);
                float val[8];
#pragma unroll
                for (int e = 0; e < 8; ++e) val[e] = siluf(w[0][e] * q3[e] + w[1][e] * q2[e] + w[2][e] * q1[e] + w[3][e] * cur[e] + bias[e]);
                *(f32x4*)(sxbc + (size_t)sb * XBC + c0) = (f32x4){val[0], val[1], val[2], val[3]}; *(f32x4*)(sxbc + (size_t)sb * XBC + c0 + 4) = (f32x4){val[4], val[5], val[6], val[7]};
                float* o0 = dout + O_NSCS + (size_t)sb * 3 * XBC + c0;
                *(f32x4*)(o0) = (f32x4){q2[0], q2[1], q2[2], q2[3]}; *(f32x4*)(o0 + 4) = (f32x4){q2[4], q2[5], q2[6], q2[7]};
                *(f32x4*)(o0 + XBC) = (f32x4){q1[0], q1[1], q1[2], q1[3]}; *(f32x4*)(o0 + XBC + 4) = (f32x4){q1[4], q1[5], q1[6], q1[7]};
                *(f32x4*)(o0 + 2 * XBC) = (f32x4){cur[0], cur[1], cur[2], cur[3]}; *(f32x4*)(o0 + 2 * XBC + 4) = (f32x4){cur[4], cur[5], cur[6], cur[7]};
            } else {
                if (t0 == 0) {
#pragma unroll
                    for (int e = 0; e < 8; ++e) { q1[e] = 0.f; q2[e] = 0.f; q3[e] = 0.f; }
                } else {
                    unpack8(*(const u32x4*)(xbcB + (size_t)(row0 - 3) * XBC + c0), q3); unpack8(*(const u32x4*)(xbcB + (size_t)(row0 - 2) * XBC + c0), q2); unpack8(*(const u32x4*)(xbcB + (size_t)(row0 - 1) * XBC + c0), q1);
                }
                unsigned ov[8][4];
                float prev[8];
#pragma unroll
                for (int i = 0; i < 8; ++i) {
                    const int row = row0 + i; float cur[8], val[8];
                    unpack8(*(const u32x4*)(xbcB + (size_t)row * XBC + c0), cur);
#pragma unroll
                    for (int e = 0; e < 8; ++e) val[e] = siluf(w[0][e] * q3[e] + w[1][e] * q2[e] + w[2][e] * q1[e] + w[3][e] * cur[e] + bias[e]);
                    if (j == 2) { u32x4 o; o.x = pk2(val[0], val[1]); o.y = pk2(val[2], val[3]); o.z = pk2(val[4], val[5]); o.w = pk2(val[6], val[7]); *(u32x4*)(BC + (size_t)row * 512 + 8 * lane) = o; }
                    if (i & 1) {
#pragma unroll
                        for (int e = 0; e < 8; ++e) ov[e][i >> 1] = pk2(prev[e], val[e]);
                    } else {
#pragma unroll
                        for (int e = 0; e < 8; ++e) prev[e] = val[e];
                    }
                    if (t0 + i >= 2045) { float* o0 = dout + O_NSCP + (size_t)(b * 3 + (t0 + i - 2045)) * XBC + c0;
                        *(f32x4*)(o0) = (f32x4){cur[0], cur[1], cur[2], cur[3]}; *(f32x4*)(o0 + 4) = (f32x4){cur[4], cur[5], cur[6], cur[7]}; }
#pragma unroll
                    for (int e = 0; e < 8; ++e) { q3[e] = q2[e]; q2[e] = q1[e]; q1[e] = cur[e]; }
                }
                const int chunk = t0 >> 7, s0 = t0 & 127;
                if (j < 2) {
#pragma unroll
                    for (int e = 0; e < 8; ++e) *(u32x4*)(xT + ((size_t)((b * 16 + chunk) * 1024 + c0 + e)) * 128 + s0) = (u32x4){ov[e][0], ov[e][1], ov[e][2], ov[e][3]};
                } else if (lane < 32) {
#pragma unroll
                    for (int e = 0; e < 8; ++e) *(u32x4*)(BT + ((size_t)((b * 16 + chunk) * 256 + 8 * lane + e)) * 128 + s0) = (u32x4){ov[e][0], ov[e][1], ov[e][2], ov[e][3]};
                }
            }
        }
    }
    SEAM(4);
    if (IN(5)) for (int rep_ = 0; rep_ < (((MK_DUPMASK >> 5) & 1) ? 2 : 1); ++rep_) { CArgs A_ = AP();
        LAS float* wl = (LAS float*)(L + wave * 512);
        const int r16 = lane & 15, quad = lane >> 4;
        for (int item = bid; item < 2048; item += G) {
            const int h = item & 15, bc = item >> 4, g = h >> 3, rowbase = bc * 128;
            float dt0, dt1, a0, a1, tot; const float aa = -__expf(a_log[h]);
            dt_scan(dtraw, rowbase, h, dt_bias[h], aa, lane, dt0, dt1, a0, a1, tot);
            wl[2 * lane] = dt0 * __expf(tot - a0); wl[2 * lane + 1] = dt1 * __expf(tot - a1);
            if (wave == 0 && lane == 0) cdec[item] = __expf(tot);
            LDS_FENCE();
            f32x4 acc[4];
#pragma unroll
            for (int pt = 0; pt < 4; ++pt) acc[pt] = (f32x4){0.f, 0.f, 0.f, 0.f};
            const bf16_t* btp = BT + ((size_t)(bc * 256 + g * 128 + 16 * wave + r16)) * 128 + quad * 8;
            const bf16_t* xtp = xT + ((size_t)(bc * 1024 + h * 64 + r16)) * 128 + quad * 8;
#pragma unroll
            for (int kk = 0; kk < 4; ++kk) {
                const f32x4 wa = *(const LAS f32x4*)(wl + 32 * kk + quad * 8), wb = *(const LAS f32x4*)(wl + 32 * kk + quad * 8 + 4);
                const bf16x8 bfr = *(const bf16x8*)(btp + 32 * kk);
#pragma unroll
                for (int pt = 0; pt < 4; ++pt) {
                    const u32x4 raw = *(const u32x4*)(xtp + (size_t)pt * 16 * 128 + 32 * kk);
                    u32x4 sc; sc.x = pk2(bflo(raw.x) * wa.x, bfhi(raw.x) * wa.y); sc.y = pk2(bflo(raw.y) * wa.z, bfhi(raw.y) * wa.w);
                    sc.z = pk2(bflo(raw.z) * wb.x, bfhi(raw.z) * wb.y); sc.w = pk2(bflo(raw.w) * wb.z, bfhi(raw.w) * wb.w);
                    acc[pt] = __builtin_amdgcn_mfma_f32_16x16x32_bf16(bfr, __builtin_bit_cast(bf16x8, sc), acc[pt], 0, 0, 0);
                }
            }
#pragma unroll
            for (int pt = 0; pt < 4; ++pt) *(f32x4*)(CS + (size_t)item * 8192 + (pt * 16 + r16) * 128 + 16 * wave + quad * 4) = acc[pt];
            LDS_FENCE();
        }
    }
    SEAM(5);
    if (IN(6)) for (int rep_ = 0; rep_ < (((MK_DUPMASK >> 6) & 1) ? 2 : 1); ++rep_) { CArgs A_ = AP();
        for (int e = bid * NTHREADS + tid; e < 262144; e += G * NTHREADS) {
            const int n4 = e & 31, p = (e >> 5) & 63, h = (e >> 11) & 15, b = e >> 15;
            f32x4 cs[16]; float dc[16];
#pragma unroll
            for (int c = 0; c < 16; ++c) { cs[c] = *(const f32x4*)(CS + ((size_t)((b * 16 + c) * 16 + h)) * 8192 + p * 128 + n4 * 4); dc[c] = cdec[(b * 16 + c) * 16 + h]; }
            f32x4 S = {0.f, 0.f, 0.f, 0.f};
#pragma unroll
            for (int c = 0; c < 16; ++c) {
                u32x2 w; w.x = pk2(S.x, S.y); w.y = pk2(S.z, S.w);
                *(u32x2*)(Sprev + ((size_t)((b * 16 + c) * 16 + h)) * 8192 + p * 128 + n4 * 4) = w;
                S = S * dc[c] + cs[c];
            }
            *(f32x4*)(dout + O_NSP + ((size_t)((b * 16 + h) * 64 + p)) * 128 + n4 * 4) = S;
        }
    }
    SEAM(6);
    if (IN(7)) for (int rep_ = 0; rep_ < (((MK_DUPMASK >> 7) & 1) ? 2 : 1); ++rep_) { CArgs A_ = AP();
        LAS unsigned char* ysh = L + wave * (16 * 1032);
        LAS float* ldt = (LAS float*)(L + 132096); LAS float* lacs = (LAS float*)(L + 136192); LAS float* red = (LAS float*)(L + 140288);
        const int r16 = lane & 15, quad = lane >> 4;
        for (int item = bid; item < 256; item += G) {
            const int g = item & 1, bc = item >> 1, rowbase = bc * 128;
            { const int h = g * 8 + wave; float dt0, dt1, a0, a1, tot; const float aa = -__expf(a_log[h]);
              dt_scan(dtraw, rowbase, h, dt_bias[h], aa, lane, dt0, dt1, a0, a1, tot);
              ldt[wave * 128 + 2 * lane] = dt0; ldt[wave * 128 + 2 * lane + 1] = dt1; lacs[wave * 128 + 2 * lane] = a0; lacs[wave * 128 + 2 * lane + 1] = a1; }
            __syncthreads();
            const bf16_t* BCp = BC + (size_t)rowbase * 512;
            const int srow = 16 * wave + r16;
            bf16x8 cfr[4];
#pragma unroll
            for (int kk = 0; kk < 4; ++kk) cfr[kk] = *(const bf16x8*)(BCp + (size_t)srow * 512 + 256 + g * 128 + 32 * kk + quad * 8);
            f32x4 cbt[8];
#pragma unroll
            for (int tt = 0; tt < 8; ++tt) { cbt[tt] = (f32x4){0.f, 0.f, 0.f, 0.f};
                if (tt <= wave) {
#pragma unroll
                    for (int kk = 0; kk < 4; ++kk) { const bf16x8 bfr = *(const bf16x8*)(BCp + (size_t)(16 * tt + r16) * 512 + g * 128 + 32 * kk + quad * 8);
                        cbt[tt] = __builtin_amdgcn_mfma_f32_16x16x32_bf16(bfr, cfr[kk], cbt[tt], 0, 0, 0); } } }
            float ss = 0.f;
            for (int hh = 0; hh < 8; ++hh) {
                const int h = g * 8 + hh; const float acs_s = lacs[hh * 128 + srow], dsk = d_skip[h];
                bf16x8 gfr[4];
#pragma unroll
                for (int kk = 0; kk < 4; ++kk) {
                    unsigned pk[4];
#pragma unroll
                    for (int half = 0; half < 2; ++half) { const int tt = 2 * kk + half;
                        const f32x4 at = *(const LAS f32x4*)(lacs + hh * 128 + 16 * tt + quad * 4), dtt = *(const LAS f32x4*)(ldt + hh * 128 + 16 * tt + quad * 4);
                        float v[4];
#pragma unroll
                        for (int r = 0; r < 4; ++r) { const int t = 16 * tt + quad * 4 + r; float x = 0.f;
                            if (t <= srow) x = cbt[tt][r] * __expf(acs_s - at[r]) * dtt[r];
                            if (t == srow) x += dsk;
                            v[r] = x; }
                        pk[2 * half] = pk2(v[0], v[1]); pk[2 * half + 1] = pk2(v[2], v[3]); }
                    gfr[kk] = __builtin_bit_cast(bf16x8, (u32x4){pk[0], pk[1], pk[2], pk[3]});
                }
                f32x4 yd[4], yo[4];
#pragma unroll
                for (int pt = 0; pt < 4; ++pt) { yd[pt] = (f32x4){0.f, 0.f, 0.f, 0.f}; yo[pt] = (f32x4){0.f, 0.f, 0.f, 0.f}; }
                const bf16_t* xtp = xT + ((size_t)(bc * 1024 + h * 64 + r16)) * 128 + quad * 4;
                const bf16_t* spp = Sprev + ((size_t)(bc * 16 + h)) * 8192 + (size_t)r16 * 128 + quad * 8;
#pragma unroll
                for (int kk = 0; kk < 4; ++kk) {
                    if (2 * kk <= wave) {
#pragma unroll
                        for (int pt = 0; pt < 4; ++pt) { const u32x2 lo2 = *(const u32x2*)(xtp + (size_t)pt * 2048 + 32 * kk), hi2 = *(const u32x2*)(xtp + (size_t)pt * 2048 + 32 * kk + 16);
                            yd[pt] = __builtin_amdgcn_mfma_f32_16x16x32_bf16(__builtin_bit_cast(bf16x8, (u32x4){lo2.x, lo2.y, hi2.x, hi2.y}), gfr[kk], yd[pt], 0, 0, 0); }
                    }
#pragma unroll
                    for (int pt = 0; pt < 4; ++pt) { const bf16x8 sa = *(const bf16x8*)(spp + (size_t)pt * 2048 + 32 * kk);
                        yo[pt] = __builtin_amdgcn_mfma_f32_16x16x32_bf16(sa, cfr[kk], yo[pt], 0, 0, 0); }
                }
                const float es = __expf(acs_s);
#pragma unroll
                for (int pt = 0; pt < 4; ++pt) {
                    const u32x2 zr = *(const u32x2*)(zB + (size_t)(rowbase + srow) * 1024 + h * 64 + pt * 16 + quad * 4);
                    const float z0 = bflo(zr.x), z1 = bfhi(zr.x), z2 = bflo(zr.y), z3 = bfhi(zr.y);
                    const float y0 = (yd[pt][0] + es * yo[pt][0]) * siluf(z0), y1 = (yd[pt][1] + es * yo[pt][1]) * siluf(z1);
                    const float y2 = (yd[pt][2] + es * yo[pt][2]) * siluf(z2), y3 = (yd[pt][3] + es * yo[pt][3]) * siluf(z3);
                    ss += (y0 * y0 + y1 * y1) + (y2 * y2 + y3 * y3);
                    *(LAS u32x2*)(ysh + r16 * 1032 + (hh * 64 + pt * 16 + quad * 4) * 2) = (u32x2){pk2(y0, y1), pk2(y2, y3)};
                }
            }
            ss += __shfl_xor(ss, 16); ss += __shfl_xor(ss, 32);
            const float rstd = 1.0f / sqrtf(ss * (1.f / 512.f) + RMS_EPS);
            LDS_FENCE();
#pragma unroll 4
            for (int q = 0; q < 32; ++q) {
                const u32x2 yr = *(const LAS u32x2*)(ysh + r16 * 1032 + (q * 16 + quad * 4) * 2);
                const f32x4 nwv = *(const f32x4*)(ssm_norm_w + g * 512 + q * 16 + quad * 4);
                u32x2 o; o.x = pk2(bflo(yr.x) * rstd * nwv.x, bfhi(yr.x) * rstd * nwv.y); o.y = pk2(bflo(yr.y) * rstd * nwv.z, bfhi(yr.y) * rstd * nwv.w);
                *(u32x2*)(ymix + (size_t)(rowbase + srow) * MIX + 1024 + g * 512 + q * 16 + quad * 4) = o;
            }
            __syncthreads();
        }
        for (int item = bid; item < 256; item += G) {
            const int g = item & 1, sb = item >> 1, h = g * 8 + wave;
            const float dt = softplusf(dtraw[(size_t)(NP + sb) * 16 + h] + dt_bias[h]); const float dA = __expf(dt * -__expf(a_log[h]));
            const float* sx = sxbc + (size_t)sb * XBC;
            const int n4 = lane & 31, ph = lane >> 5;
            const f32x4 Bv = *(const f32x4*)(sx + 1024 + g * 128 + 4 * n4), Cv = *(const f32x4*)(sx + 1280 + g * 128 + 4 * n4);
            const float* sp = state_ssm + ((size_t)(sb * 16 + h) * 64) * 128 + 4 * n4; float* op = dout + O_NSS + ((size_t)(sb * 16 + h) * 64) * 128 + 4 * n4;
            float ymine = 0.f;
#pragma unroll 8
            for (int i = 0; i < 32; ++i) {
                const int p = i + 32 * ph; const float xv = sx[h * 64 + p] * dt;
                const f32x4 S = *(const f32x4*)(sp + (size_t)p * 128); const f32x4 Sn = S * dA + Bv * xv;
                *(f32x4*)(op + (size_t)p * 128) = Sn;
                float part = (Cv.x * Sn.x + Cv.y * Sn.y) + (Cv.z * Sn.z + Cv.w * Sn.w);
                part += __shfl_xor(part, 1); part += __shfl_xor(part, 2); part += __shfl_xor(part, 4); part += __shfl_xor(part, 8); part += __shfl_xor(part, 16);
                if ((lane & 31) == i) ymine = part;
            }
            const float xme = sx[h * 64 + lane];
            const float zz = bflo((unsigned)zB[(size_t)(NP + sb) * 1024 + h * 64 + lane]);
            const float y = (ymine + d_skip[h] * xme) * siluf(zz);
            const float s2 = wave_sum(y * y);
            if (lane == 0) red[wave] = s2;
            __syncthreads();
            float tot = 0.f;
#pragma unroll
            for (int q = 0; q < 8; ++q) tot += red[q];
            const float rstd = 1.0f / sqrtf(tot * (1.f / 512.f) + RMS_EPS);
            ymix[(size_t)(NP + sb) * MIX + 1024 + g * 512 + wave * 64 + lane] = (bf16_t)f2bf(y * rstd * ssm_norm_w[g * 512 + wave * 64 + lane]);
            __syncthreads();
        }
    }
    SEAM(7);
    if (IN(8)) for (int rep_ = 0; rep_ < (((MK_DUPMASK >> 8) & 1) ? 2 : 1); ++rep_) { CArgs A_ = AP();
        pg8::Gemm g{ymix, WoutT, NP, DM, MIX}; pg8::StaticOrder S; S.init(NP, DM, G, bid);
        pg8::EpiRes E{x_prompt, pre1, mod + 2048, ALPHA};
        pg8::gemm_phase<pg8::EpiRes, pg8::StaticOrder, true, true>(L, g, S, E);
        __syncthreads();
        EpiResS ES{x_sample, pre1 + (size_t)NP * DM, mod + 8 * 6144 + 2048};
        small_gemm<4>((LAS float*)L, ymix + (size_t)NP * MIX, MIX, WoutT, MIX, 8, 8 * 64, MIX, ES, bid, G);
    }
    SEAM(8);
    if (IN(9)) for (int rep_ = 0; rep_ < (((MK_DUPMASK >> 9) & 1) ? 2 : 1); ++rep_) { CArgs A_ = AP();
        for (int r = gw; r < NR; r += NGW) {
            f32x4 v[4]; ln_row(pre1 + (size_t)r * DM, ln1_g, ln1_b, lane, v);
            const float* mrow = mod + (size_t)(r < NP ? (r >> 11) : 8 + r - NP) * 6144;
#pragma unroll
            for (int j = 0; j < 4; ++j) { *((f32x4*)(Yf + (size_t)r * DM) + lane + 64 * j) = v[j];
                const f32x4 sh = *((const f32x4*)(mrow + 3072) + lane + 64 * j), sc = *((const f32x4*)(mrow + 4096) + lane + 64 * j);
                const f32x4 u = v[j] * (sc + 1.0f) + sh; u32x2 w; w.x = pk2(u.x, u.y); w.y = pk2(u.z, u.w); *((u32x2*)(vbf + (size_t)r * DM) + lane + 64 * j) = w; }
        }
    }
    SEAM(9);
    if (IN(10)) for (int rep_ = 0; rep_ < (((MK_DUPMASK >> 10) & 1) ? 2 : 1); ++rep_) { CArgs A_ = AP();
        pg8::Gemm g{vbf, WupT, NP, DFF, DM}; pg8::StaticOrder S; S.init(NP, DFF, G, bid);
        pg8::EpiHid E{hid, DFF};
        pg8::gemm_phase<pg8::EpiHid, pg8::StaticOrder, true, true>(L, g, S, E);
        __syncthreads();
        EpiHidS ES{hid};
        small_gemm<1>((LAS float*)L, vbf + (size_t)NP * DM, DM, WupT, DM, 8, 8 * 256, 1024, ES, bid, G);
    }
    SEAM(10);
    if (IN(11)) for (int rep_ = 0; rep_ < (((MK_DUPMASK >> 11) & 1) ? 2 : 1); ++rep_) { CArgs A_ = AP();
        pg8::Gemm g{hid, WdownT, NP, DM, DFF}; pg8::StaticOrder S; S.init(NP, DM, G, bid);
        pg8::EpiRes E{Yf, Yf, mod + 5120, ALPHA};
        pg8::gemm_phase<pg8::EpiRes, pg8::StaticOrder, true, true>(L, g, S, E);
        __syncthreads();
        EpiResS ES{Yf + (size_t)NP * DM, Yf + (size_t)NP * DM, mod + 8 * 6144 + 5120};
        small_gemm<4>((LAS float*)L, hid + (size_t)NP * DFF, DFF, WdownT, DFF, 8, 8 * 64, DFF, ES, bid, G);
    }
    SEAM(11);
    if (IN(12)) for (int rep_ = 0; rep_ < (((MK_DUPMASK >> 12) & 1) ? 2 : 1); ++rep_) { CArgs A_ = AP();
        for (int r = gw; r < NR; r += NGW) {
            f32x4 v[4]; ln_row(Yf + (size_t)r * DM, ln2_g, ln2_b, lane, v);
#pragma unroll
            for (int j = 0; j < 4; ++j) *((f32x4*)(Yf + (size_t)r * DM) + lane + 64 * j) = v[j];
        }
    }
#undef IN
#undef SEAM
}
#undef dout
#undef x_prompt
#undef x_sample
#undef state_conv
#undef state_ssm_conv
#undef state_ssm
#undef c_prompt
#undef c_sample
#undef w_ada
#undef b_ada
#undef w_in
#undef conv_w
#undef conv_norm_w
#undef ssm_conv_w
#undef ssm_conv_b
#undef dt_bias
#undef a_log
#undef d_skip
#undef ssm_norm_w
#undef w_out
#undef ln1_g
#undef ln1_b
#undef w_up
#undef w_down
#undef ln2_g
#undef ln2_b
#undef WadaT
#undef WinT
#undef WoutT
#undef WupT
#undef WdownT
#undef cbf
#undef mod
#undef dtraw
#undef sxbc
#undef cdec
#undef ubf
#undef xT
#undef vbf
#undef gbB
#undef CS
#undef pre1
#undef hid
#undef hvB
#undef xbcB
#undef Sprev
#undef zB
#undef BC
#undef BT
#undef gcB
#undef ymix
#undef Yf

#ifndef MK_N_LAUNCHES
#define MK_N_LAUNCHES 1
#endif
constexpr int N_PHASES = 13;
extern "C" void kernel_launch(void* const* d_in, const int* in_sizes, int n_in, void* d_out, int out_size, void* d_ws, size_t ws_size, hipStream_t stream) {
    static int grid = 0;
    if (grid == 0) {
        int dev = 0, cus = 0, per_cu = 0;
        hipGetDevice(&dev);
        hipDeviceGetAttribute(&cus, hipDeviceAttributeMultiprocessorCount, dev);
        if (hipFuncSetAttribute((const void*)mk_fwd, hipFuncAttributeMaxDynamicSharedMemorySize, LDS_BYTES) != hipSuccess) { fprintf(stderr, "kernel_launch: hipFuncSetAttribute failed\n"); }
        if (hipOccupancyMaxActiveBlocksPerMultiprocessor(&per_cu, (const void*)mk_fwd, NTHREADS, LDS_BYTES) != hipSuccess || per_cu < 1) { fprintf(stderr, "kernel_launch: occupancy query says %d\n", per_cu); per_cu = 1; }
        (void)hipGetLastError();
        grid = cus * (per_cu > 1 ? 1 : per_cu);
        if (grid > 256) grid = 256;
    }
    Args a{};
    for (int i = 0; i < 25; ++i) a.in[i] = (const float*)d_in[i];
    a.out = (float*)d_out; a.ws = (unsigned char*)d_ws;
    if (hipMemsetAsync(d_ws, 0, 65536, stream) != hipSuccess) fprintf(stderr, "kernel_launch: memset of the control words failed\n");
    if (MK_N_LAUNCHES == 1) {
        a.ph_lo = 0; a.ph_hi = N_PHASES;
        void* kargs[] = {&a};
        hipError_t e = hipLaunchCooperativeKernel((const void*)mk_fwd, dim3(grid), dim3(NTHREADS), kargs, LDS_BYTES, stream);
        if (e != hipSuccess) fprintf(stderr, "cooperative launch failed: %s (grid %d)\n", hipGetErrorString(e), grid);
    } else {
        for (int p = 0; p < N_PHASES; ++p) { a.ph_lo = p; a.ph_hi = p + 1; hipLaunchKernelGGL(mk_fwd, dim3(grid), dim3(NTHREADS), LDS_BYTES, stream, a); }
    }
}
```

```cpp
#include <hip/hip_runtime.h>
#include <hip/hip_cooperative_groups.h>
#include <cstdio>
#include <cstdint>
namespace cg = cooperative_groups;
namespace pg8 {
#define PG8_LAS __attribute__((address_space(3)))
typedef unsigned short bf16_t;
typedef short bf16x8 __attribute__((ext_vector_type(8)));
typedef float f32x4 __attribute__((ext_vector_type(4)));
typedef unsigned u32x4 __attribute__((ext_vector_type(4)));
constexpr int BM = 256, BK = 64, HALF = 128, HTB = HALF * BK * 2  , STAGE_BYTES = 8 * HTB, NXCD = 8, WGM = 8;

__host__ __device__ __forceinline__ int lds_byte(int r, int c) { const int st = (r >> 4) * 2 + (c >> 5), rr = r & 15, cc = c & 31, ob = rr * 64 + cc * 2; return st * 1024 + (ob ^ (((ob >> 9) & 1) << 5)); }
__host__ __device__ __forceinline__ void stage_rc(int b, int& R, int& C) { const int st = b / 1024, sb = b % 1024, swz = sb ^ (((sb >> 9) & 1) << 5); R = (st >> 1) * 16 + swz / 64; C = (st & 1) * 32 + (swz % 64) / 2; }
__host__ __device__ __forceinline__ int perm32(int rho) { const int n = rho >> 4, i = rho & 15; return 8 * (i >> 2) + 4 * n + (i & 3); }

struct Unit { int pm, pn; };
struct Gemm { const bf16_t* A; const bf16_t* Bt; int M, N, K; };

struct StaticOrder {
    int nM, nN, nwg, G, c;
    __host__ __device__ void init(int M, int N, int G_, int c_) { nM = M / BM; nN = N / BM; nwg = nM * nN; G = G_; c = c_; }
    __host__ __device__ bool next(int i, Unit& u) const {
        const long L = (long)i * G + c; if (L >= nwg) return false;
        int wgid = (int)L; { const int q = nwg / NXCD, r = nwg % NXCD, xcd = wgid % NXCD, off = wgid / NXCD; wgid = (xcd < r ? xcd * (q + 1) : r * (q + 1) + (xcd - r) * q) + off; }
        const int nig = WGM * nN, gid = wgid / nig, fm = gid * WGM, gsz = (nM - fm) < WGM ? (nM - fm) : WGM;
        u.pm = fm + ((wgid % nig) % gsz); u.pn = (wgid % nig) / gsz; return true;
    }
    __device__ __forceinline__ void a_ready(const Unit&) const {}
    __device__ __forceinline__ void done(const Unit&) const {}
};

__device__ __forceinline__ unsigned cvt_pk_bf16(float lo, float hi) { unsigned r; asm volatile("v_cvt_pk_bf16_f32 %0, %1, %2" : "=v"(r) : "v"(lo), "v"(hi)); return r; }
typedef float f32x2 __attribute__((ext_vector_type(2)));
typedef unsigned u32x2 __attribute__((ext_vector_type(2)));
struct EpiProj {
    static constexpr bool PERM = true, AFTER_DRAIN = false;
    bf16_t *gb, *gc, *hv, *z, *xbc;
    __device__ __forceinline__ void operator()(const f32x4 (&acc)[2][2][4][2], const Unit& u, int wr, int wc, int fr, int fq) const {
        const int colt = u.pn * BM; bf16_t* base; int ldc;
        if (colt < 1024) { base = gb + colt; ldc = 1024; }
        else if (colt < 2048) { base = gc + (colt - 1024); ldc = 1024; }
        else if (colt < 3072) { base = hv + (colt - 2048); ldc = 1024; }
        else if (colt < 4096) { base = z + (colt - 3072); ldc = 1024; }
        else { base = xbc + (colt - 4096); ldc = 1536; }
        const int row0 = u.pm * BM + wr * 64 + fr, col0 = wc * 32 + 8 * fq;
#pragma unroll
        for (int ai = 0; ai < 2; ++ai)
#pragma unroll
            for (int m = 0; m < 4; ++m) { bf16_t* rowp = base + (size_t)(row0 + ai * HALF + m * 16) * ldc + col0;
#pragma unroll
                for (int bj = 0; bj < 2; ++bj) { const f32x4 v0 = acc[ai][bj][m][0], v1 = acc[ai][bj][m][1];
                    u32x4 w; w.x = cvt_pk_bf16(v0[0], v0[1]); w.y = cvt_pk_bf16(v0[2], v0[3]); w.z = cvt_pk_bf16(v1[0], v1[1]); w.w = cvt_pk_bf16(v1[2], v1[3]);
                    *(u32x4*)(rowp + bj * HALF) = w; } }
    }
};
struct EpiHid {
    static constexpr bool PERM = true, AFTER_DRAIN = false;
    bf16_t* O; int ldc;
    __device__ __forceinline__ void operator()(const f32x4 (&acc)[2][2][4][2], const Unit& u, int wr, int wc, int fr, int fq) const {
        const int row0 = u.pm * BM + wr * 64 + fr, col0 = u.pn * BM + wc * 32 + 8 * fq;
#pragma unroll
        for (int ai = 0; ai < 2; ++ai)
#pragma unroll
            for (int m = 0; m < 4; ++m) { bf16_t* rowp = O + (size_t)(row0 + ai * HALF + m * 16) * ldc + col0;
#pragma unroll
                for (int bj = 0; bj < 2; ++bj) { f32x4 v0 = acc[ai][bj][m][0], v1 = acc[ai][bj][m][1];
#pragma unroll
                    for (int e = 0; e < 4; ++e) { float a = fmaxf(v0[e], 0.f), b = fmaxf(v1[e], 0.f); v0[e] = a * a; v1[e] = b * b; }
                    u32x4 w; w.x = cvt_pk_bf16(v0[0], v0[1]); w.y = cvt_pk_bf16(v0[2], v0[3]); w.z = cvt_pk_bf16(v1[0], v1[1]); w.w = cvt_pk_bf16(v1[2], v1[3]);
                    *(u32x4*)(rowp + bj * HALF) = w; } }
    }
};
struct EpiRes {
    static constexpr bool PERM = false, AFTER_DRAIN = false;
    const float* base; float* out; const float* gate  ; float alpha;
    __device__ __forceinline__ void operator()(const f32x4 (&acc)[2][2][4][2], const Unit& u, int wr, int wc, int fr, int fq) const {
        const int b = (u.pm * BM) >> 11; const float* gp = gate + (size_t)b * 6144;
        const int col0 = u.pn * BM + wc * 32 + 4 * fq;
        f32x4 gv[2][2];
#pragma unroll
        for (int bj = 0; bj < 2; ++bj)
#pragma unroll
            for (int n = 0; n < 2; ++n) { gv[bj][n] = *(const f32x4*)(gp + col0 + bj * HALF + n * 16); gv[bj][n] = gv[bj][n] + 1.0f; }
#pragma unroll
        for (int ai = 0; ai < 2; ++ai)
#pragma unroll
            for (int m = 0; m < 4; ++m) { const size_t off = (size_t)(u.pm * BM + ai * HALF + wr * 64 + m * 16 + fr) * 1024 + col0;
#pragma unroll
                for (int bj = 0; bj < 2; ++bj)
#pragma unroll
                    for (int n = 0; n < 2; ++n) { const f32x4 bs = *(const f32x4*)(base + off + bj * HALF + n * 16);
                        *(f32x4*)(out + off + bj * HALF + n * 16) = bs * alpha + gv[bj][n] * acc[ai][bj][m][n]; } }
    }
};

template <class Epi, class Sched, bool ALIGN_EPI = false, bool SP2 = false>
__device__ __forceinline__ void gemm_phase(PG8_LAS unsigned char* lds, const Gemm g, const Sched& S, const Epi& E) {
    const int tid = threadIdx.x, wid = __builtin_amdgcn_readfirstlane(tid >> 6), lane = tid & 63, wr = wid >> 2, wc = wid & 3, fr = lane & 15, fq = lane >> 4;
    const int K = g.K, nt = K / BK;
    unsigned voffA[2], voffB[2];
#pragma unroll
    for (int i = 0; i < 2; ++i) { int R, C; stage_rc(tid * 16 + i * 8192, R, C); const int Rb = Epi::PERM ? ((R & ~31) + perm32(R & 31)) : R;
        voffA[i] = (unsigned)(R * K + C) * 2u; voffB[i] = (unsigned)(Rb * K + C) * 2u; }
    const size_t kstep = (size_t)(BK * 2);
    const size_t hstep = (size_t)HALF * K * 2;
    const size_t tstep = 2 * hstep;
    const unsigned ldsw = (unsigned)wid * 1024u;
    const int aoff = lds_byte(wr * 64 + fr, fq * 8), boff = lds_byte(wc * 32 + fr, fq * 8);
#define PG8_SA(b, h) (((b) * 2 + (h)) * HTB)
#define PG8_SB(b, h) ((4 + (b) * 2 + (h)) * HTB)
#define PG8_STAGE(bufoff, gbase, voff) do { _Pragma("unroll") for (int _i = 0; _i < 2; ++_i) \
        __builtin_amdgcn_global_load_lds((const unsigned*)((const char*)(gbase) + (voff)[_i]), (PG8_LAS unsigned*)(lds + (bufoff) + ldsw + _i * 8192), 16, 0, 0); } while (0)
#define PG8_LDA(dst, b, h) do { _Pragma("unroll") for (int m = 0; m < 4; ++m) _Pragma("unroll") for (int k = 0; k < 2; ++k) dst[m][k] = *(const PG8_LAS bf16x8*)(lds + PG8_SA(b, h) + aoff + m * 2048 + k * 1024); } while (0)
#define PG8_LDB(dst, b, h) do { _Pragma("unroll") for (int n = 0; n < 2; ++n) _Pragma("unroll") for (int k = 0; k < 2; ++k) dst[n][k] = *(const PG8_LAS bf16x8*)(lds + PG8_SB(b, h) + boff + n * 2048 + k * 1024); } while (0)
#define PG8_MMA(ai, bj, At, Bt) do { __builtin_amdgcn_s_setprio(1); _Pragma("unroll") for (int m = 0; m < 4; ++m) _Pragma("unroll") for (int n = 0; n < 2; ++n) _Pragma("unroll") for (int k = 0; k < 2; ++k) \
        acc[ai][bj][m][n] = __builtin_amdgcn_mfma_f32_16x16x32_bf16(Bt[n][k], At[m][k], acc[ai][bj][m][n], 0, 0, 0); __builtin_amdgcn_s_setprio(0); } while (0)
#define PG8_WAIT_V(n) asm volatile("s_waitcnt vmcnt(" #n ")" ::: "memory")
#define PG8_WAIT_L(n) asm volatile("s_waitcnt lgkmcnt(" #n ")" ::: "memory")
#define PG8_BAR __builtin_amdgcn_s_barrier()
#define PG8_SCHED __builtin_amdgcn_sched_barrier(0)
    Unit cur, nxt; int ui = 0;
    if (!S.next(0, cur)) return;
    f32x4 acc[2][2][4][2];
#pragma unroll
    for (int a = 0; a < 2; ++a)
#pragma unroll
        for (int b = 0; b < 2; ++b)
#pragma unroll
            for (int m = 0; m < 4; ++m)
#pragma unroll
                for (int n = 0; n < 2; ++n) acc[a][b][m][n] = (f32x4){0.f, 0.f, 0.f, 0.f};
    bf16x8 At[4][2], B0[2][2], B1[2][2];
    const char* cA = (const char*)g.A + (size_t)cur.pm * tstep; const char* cB = (const char*)g.Bt + (size_t)cur.pn * tstep;
    S.a_ready(cur);
    if constexpr (SP2) {
        PG8_STAGE(PG8_SB(0, 0), cB, voffB); PG8_STAGE(PG8_SB(0, 1), cB + hstep, voffB); PG8_STAGE(PG8_SA(0, 0), cA, voffA); PG8_STAGE(PG8_SA(0, 1), cA + hstep, voffA);
        if (wr == 1) PG8_BAR;
        PG8_WAIT_V(2); PG8_BAR;
        PG8_STAGE(PG8_SB(1, 0), cB + kstep, voffB); PG8_STAGE(PG8_SA(1, 0), cA + kstep, voffA); PG8_STAGE(PG8_SB(1, 1), cB + hstep + kstep, voffB);
        PG8_WAIT_V(6); PG8_BAR;
    } else {
        PG8_STAGE(PG8_SB(0, 0), cB, voffB); PG8_STAGE(PG8_SA(0, 0), cA, voffA); PG8_STAGE(PG8_SB(0, 1), cB + hstep, voffB); PG8_STAGE(PG8_SA(0, 1), cA + hstep, voffA);
        if (wr == 1) PG8_BAR;
        PG8_WAIT_V(4); PG8_BAR;
        PG8_STAGE(PG8_SB(1, 0), cB + kstep, voffB); PG8_STAGE(PG8_SA(1, 0), cA + kstep, voffA); PG8_STAGE(PG8_SB(1, 1), cB + hstep + kstep, voffB);
        PG8_WAIT_V(6); PG8_BAR;
    }
    for (;;) {
        const bool has_next = S.next(ui + 1, nxt);
        const char* nA = has_next ? (const char*)g.A + (size_t)nxt.pm * tstep : cA; const char* nB = has_next ? (const char*)g.Bt + (size_t)nxt.pn * tstep : cB;
        for (int t = 0; t < nt; t += 2) {
            const bool last = (t == nt - 2);
            const char* a1 = cA + (size_t)(t + 1) * kstep;
            const char* a2 = last ? nA : cA + (size_t)(t + 2) * kstep; const char* b2 = last ? nB : cB + (size_t)(t + 2) * kstep;
            const char* a3 = a2 + kstep; const char* b3 = b2 + kstep;
            if (last && has_next) S.a_ready(nxt);
            if constexpr (SP2) {
            PG8_LDB(B0, 0, 0); PG8_LDB(B1, 0, 1); PG8_SCHED; PG8_LDA(At, 0, 0); PG8_STAGE(PG8_SA(1, 1), a1 + hstep, voffA);
            PG8_WAIT_V(8); PG8_WAIT_L(0); PG8_BAR; PG8_MMA(0, 0, At, B0); PG8_MMA(0, 1, At, B1); PG8_BAR; PG8_SCHED;
            PG8_LDA(At, 0, 1); PG8_STAGE(PG8_SB(0, 0), b2, voffB); PG8_STAGE(PG8_SB(0, 1), b2 + hstep, voffB); PG8_STAGE(PG8_SA(0, 0), a2, voffA);
            PG8_WAIT_V(8); PG8_WAIT_L(0); PG8_BAR; PG8_MMA(1, 0, At, B0); PG8_MMA(1, 1, At, B1); PG8_BAR; PG8_SCHED;
            PG8_LDB(B0, 1, 0); PG8_LDB(B1, 1, 1); PG8_SCHED; PG8_LDA(At, 1, 0); PG8_STAGE(PG8_SA(0, 1), a2 + hstep, voffA);
            PG8_WAIT_V(8); PG8_WAIT_L(0); PG8_BAR; PG8_MMA(0, 0, At, B0); PG8_MMA(0, 1, At, B1); PG8_BAR; PG8_SCHED;
            PG8_LDA(At, 1, 1); PG8_STAGE(PG8_SB(1, 0), b3, voffB); PG8_STAGE(PG8_SB(1, 1), b3 + hstep, voffB); PG8_STAGE(PG8_SA(1, 0), a3, voffA);
            PG8_WAIT_V(8); PG8_WAIT_L(0); PG8_BAR; PG8_MMA(1, 0, At, B0); PG8_MMA(1, 1, At, B1); PG8_BAR; PG8_SCHED;
            } else {
            PG8_LDB(B0, 0, 0); PG8_SCHED; PG8_LDA(At, 0, 0); PG8_STAGE(PG8_SA(1, 1), a1 + hstep, voffA);
            PG8_WAIT_L(8); PG8_BAR; PG8_WAIT_L(0); PG8_MMA(0, 0, At, B0); PG8_BAR; PG8_SCHED;
            PG8_LDB(B1, 0, 1); PG8_STAGE(PG8_SB(0, 0), b2, voffB);
            PG8_BAR; PG8_WAIT_L(0); PG8_MMA(0, 1, At, B1); PG8_BAR;
            PG8_LDA(At, 0, 1); PG8_STAGE(PG8_SA(0, 0), a2, voffA);
            PG8_BAR; PG8_WAIT_L(0); PG8_MMA(1, 0, At, B0); PG8_BAR; PG8_SCHED;
            PG8_STAGE(PG8_SB(0, 1), b2 + hstep, voffB);
            PG8_WAIT_V(6); PG8_BAR; PG8_MMA(1, 1, At, B1); PG8_BAR;
            PG8_LDB(B0, 1, 0); PG8_SCHED; PG8_LDA(At, 1, 0); PG8_STAGE(PG8_SA(0, 1), a2 + hstep, voffA);
            PG8_WAIT_L(8); PG8_BAR; PG8_WAIT_L(0); PG8_MMA(0, 0, At, B0); PG8_BAR; PG8_SCHED;
            PG8_LDB(B1, 1, 1); PG8_STAGE(PG8_SB(1, 0), b3, voffB);
            PG8_BAR; PG8_WAIT_L(0); PG8_MMA(0, 1, At, B1); PG8_BAR;
            PG8_LDA(At, 1, 1); PG8_STAGE(PG8_SA(1, 0), a3, voffA);
            PG8_BAR; PG8_WAIT_L(0); PG8_MMA(1, 0, At, B0); PG8_BAR; PG8_SCHED;
            PG8_STAGE(PG8_SB(1, 1), b3 + hstep, voffB);
            PG8_WAIT_V(6); PG8_BAR; PG8_MMA(1, 1, At, B1); PG8_BAR;
            }
        }
        if constexpr (ALIGN_EPI) { if (wr == 0) PG8_BAR; }
        if constexpr (!Epi::AFTER_DRAIN) { E(acc, cur, wr, wc, fr, fq); S.done(cur); }
        if (!has_next) break;
#pragma unroll
        for (int a = 0; a < 2; ++a)
#pragma unroll
            for (int b = 0; b < 2; ++b)
#pragma unroll
                for (int m = 0; m < 4; ++m)
#pragma unroll
                    for (int n = 0; n < 2; ++n) acc[a][b][m][n] = (f32x4){0.f, 0.f, 0.f, 0.f};
        cur = nxt; cA = nA; cB = nB; ++ui;
        if constexpr (ALIGN_EPI) { if (wr == 1) PG8_BAR; }
    }
    PG8_WAIT_V(0);
    if constexpr (!ALIGN_EPI) { if (wr == 0) PG8_BAR; }
    PG8_BAR;
    if constexpr (Epi::AFTER_DRAIN) { E.fused(acc, cur, wr, wc, fr, fq, lds, wid, lane); S.done(cur); }
#undef PG8_SA
#undef PG8_SB
#undef PG8_STAGE
#undef PG8_LDA
#undef PG8_LDB
#undef PG8_MMA
#undef PG8_WAIT_V
#undef PG8_WAIT_L
#undef PG8_BAR
#undef PG8_SCHED
}
}

#define LAS __attribute__((address_space(3)))
typedef unsigned short bf16_t;
typedef short bf16x8 __attribute__((ext_vector_type(8)));
typedef short bf16x4 __attribute__((ext_vector_type(4)));
typedef float f32x4 __attribute__((ext_vector_type(4)));
typedef unsigned u32x4 __attribute__((ext_vector_type(4)));
typedef unsigned u32x2 __attribute__((ext_vector_type(2)));

constexpr int DM = 1024, NP = 16384, NSMP = 128, NR = NP + NSMP, NINW = 5648, NINM = 5632, XBC = 1536, DFF = 4096, MIX = 2048;
constexpr float ALPHA = 1.189207115002721f, LN_EPS = 1e-5f, RMS_EPS = 1e-5f;
constexpr int NWAVES = 8, NTHREADS = 512;
constexpr int LDS_BYTES = 147456;
constexpr size_t O_Y = 0, O_NCP = 16908288, O_NSCP = 16924672, O_NSP = 16961536, O_NCS = 18010112, O_NSCS = 18272256, O_NSS = 18862080;
constexpr size_t MiB = 1u << 20;
constexpr size_t WS_WADA = 1 * MiB, WS_BT = 1 * MiB, WS_WIN = 13 * MiB, WS_WOUT = 24 * MiB, WS_WUP = 28 * MiB, WS_WDOWN = 36 * MiB;
constexpr size_t WS_CBF = 44 * MiB, WS_MOD = 45 * MiB, WS_DTRAW = 49 * MiB, WS_SXBC = 50 * MiB + 512 * 1024, WS_CDEC = 51 * MiB + 512 * 1024;
constexpr size_t WS_S0 = 52 * MiB, WS_S1 = 85 * MiB, WS_S2 = 118 * MiB, WS_S3 = 151 * MiB, WS_S4 = 200 * MiB, WS_S5 = 233 * MiB;

struct Args {
    const float* in[25]; float* out; unsigned char* ws; int ph_lo, ph_hi;
};
typedef const __attribute__((address_space(4))) Args* CArgs;
#define AP() ({ CArgs _p = (CArgs)__builtin_amdgcn_kernarg_segment_ptr(); asm volatile("" : "+s"(_p)); _p; })

__device__ __forceinline__ unsigned f2bf(float f) { unsigned u = __builtin_bit_cast(unsigned, f); return (u + 0x7fffu + ((u >> 16) & 1u)) >> 16; }
__device__ __forceinline__ unsigned pk2(float lo, float hi) { return pg8::cvt_pk_bf16(lo, hi); }
__device__ __forceinline__ float bflo(unsigned u) { return __builtin_bit_cast(float, u << 16); }
__device__ __forceinline__ float bfhi(unsigned u) { return __builtin_bit_cast(float, u & 0xffff0000u); }
__device__ __forceinline__ void unpack8(const u32x4 v, float* f) { f[0] = bflo(v.x); f[1] = bfhi(v.x); f[2] = bflo(v.y); f[3] = bfhi(v.y); f[4] = bflo(v.z); f[5] = bfhi(v.z); f[6] = bflo(v.w); f[7] = bfhi(v.w); }
__device__ __forceinline__ float wave_sum(float v) {
#pragma unroll
    for (int o = 1; o < 64; o <<= 1) v += __shfl_xor(v, o);
    return v;
}
__device__ __forceinline__ float siluf(float x) { return x / (1.0f + __expf(-x)); }
__device__ __forceinline__ float softplusf(float x) { return x > 20.f ? x : log1pf(__expf(x)); }
#define LDS_FENCE() asm volatile("s_waitcnt lgkmcnt(0)" ::: "memory")

__device__ __forceinline__ void transpose_item(const float* W, int ldw, int nblk, int K, bf16_t* WT, LAS float* scr, int item, int lane) {
    const int kb = item / nblk, nb = item % nblk, k0 = 64 * kb, n0 = 32 * nb;
#pragma unroll
    for (int i = 0; i < 32; ++i) { const int kk = 2 * i + (lane >> 5); scr[kk * 33 + (lane & 31)] = W[(size_t)(k0 + kk) * ldw + n0 + (lane & 31)]; }
    LDS_FENCE();
    const int c = lane & 7;
#pragma unroll
    for (int j = 0; j < 4; ++j) { const int n = (lane >> 3) + 8 * j; const LAS float* s = scr + (8 * c) * 33 + n;
        u32x4 o; o.x = pk2(s[0 * 33], s[1 * 33]); o.y = pk2(s[2 * 33], s[3 * 33]); o.z = pk2(s[4 * 33], s[5 * 33]); o.w = pk2(s[6 * 33], s[7 * 33]);
        *(u32x4*)(WT + (size_t)(n0 + n) * K + k0 + 8 * c) = o; }
    LDS_FENCE();
}

template <int KS, class Epi>
__device__ __forceinline__ void small_gemm(LAS float* red, const bf16_t* A, int lda, const bf16_t* Bt, int ldb, int Mtiles, int ntiles_total, int K, const Epi& epi, int it0, int itstride) {
    const int tid = threadIdx.x, wave = __builtin_amdgcn_readfirstlane(tid >> 6), lane = tid & 63, r16 = lane & 15, quad = lane >> 4;
    constexpr int TPW = 8 / KS;
    const int sub = wave / KS, ks = wave % KS, kchunk = K / KS;
    const int niter = (ntiles_total + TPW - 1) / TPW;
    for (int it = it0; it < niter; it += itstride) {
        const int tile = it * TPW + sub; const bool valid = tile < ntiles_total;
        f32x4 acc = {0.f, 0.f, 0.f, 0.f}; int mt = 0, nt = 0;
        if (valid) {
            mt = tile % Mtiles; nt = tile / Mtiles;
            const bf16_t* ap = A + (size_t)(mt * 16 + r16) * lda + ks * kchunk + quad * 8;
            const bf16_t* bp = Bt + (size_t)(nt * 16 + r16) * ldb + ks * kchunk + quad * 8;
            for (int k = 0; k < kchunk; k += 512) {
                bf16x8 a[16], b[16];
#pragma unroll
                for (int j = 0; j < 16; ++j) { a[j] = *(const bf16x8*)(ap + k + j * 32); b[j] = *(const bf16x8*)(bp + k + j * 32); }
#pragma unroll
                for (int j = 0; j < 16; ++j) acc = __builtin_amdgcn_mfma_f32_16x16x32_bf16(b[j], a[j], acc, 0, 0, 0);
            }
        }
        if constexpr (KS > 1) {
            *(LAS f32x4*)(red + (wave * 64 + lane) * 4) = acc;
            __syncthreads();
            if (ks == 0) {
#pragma unroll
                for (int q = 1; q < KS; ++q) acc += *(const LAS f32x4*)(red + ((wave + q) * 64 + lane) * 4);
            }
            __syncthreads();
        }
        if (valid && ks == 0) epi(mt * 16 + r16, nt * 16 + quad * 4, acc);
    }
}
struct EpiMod { float* mod; const float* b_ada;
    __device__ __forceinline__ void operator()(int row, int col, f32x4 v) const { if (row < 136) *(f32x4*)(mod + (size_t)row * 6144 + col) = v + *(const f32x4*)(b_ada + col); } };
struct EpiProjS { bf16_t *gb, *gc, *hv, *z, *xbc;
    __device__ __forceinline__ void operator()(int row, int col, f32x4 v) const {
        bf16_t* base; int ldc; int c = col;
        if (c < 1024) { base = gb; ldc = 1024; } else if (c < 2048) { base = gc; c -= 1024; ldc = 1024; } else if (c < 3072) { base = hv; c -= 2048; ldc = 1024; }
        else if (c < 4096) { base = z; c -= 3072; ldc = 1024; } else { base = xbc; c -= 4096; ldc = 1536; }
        u32x2 w; w.x = pk2(v[0], v[1]); w.y = pk2(v[2], v[3]); *(u32x2*)(base + (size_t)(NP + row) * ldc + c) = w; } };
struct EpiHidS { bf16_t* O;
    __device__ __forceinline__ void operator()(int row, int col, f32x4 v) const {
#pragma unroll
        for (int e = 0; e < 4; ++e) { const float a = fmaxf(v[e], 0.f); v[e] = a * a; }
        u32x2 w; w.x = pk2(v[0], v[1]); w.y = pk2(v[2], v[3]); *(u32x2*)(O + (size_t)(NP + row) * DFF + col) = w; } };
struct EpiResS { const float* base  ; float* out; const float* gate  ;
    __device__ __forceinline__ void operator()(int row, int col, f32x4 v) const {
        const f32x4 g = *(const f32x4*)(gate + (size_t)row * 6144 + col) + 1.0f; const f32x4 bs = *(const f32x4*)(base + (size_t)row * 1024 + col);
        *(f32x4*)(out + (size_t)row * 1024 + col) = bs * ALPHA + g * v; } };

__device__ __forceinline__ void dt_scan(const float* dtraw, int rowbase, int h, float dtb, float a, int lane, float& dt0, float& dt1, float& acs0, float& acs1, float& total) {
    const float r0 = dtraw[(size_t)(rowbase + 2 * lane) * 16 + h] + dtb, r1 = dtraw[(size_t)(rowbase + 2 * lane + 1) * 16 + h] + dtb;
    dt0 = softplusf(r0); dt1 = softplusf(r1);
    const float d0 = dt0 * a, d1 = dt1 * a;
    float incl = d0 + d1;
#pragma unroll
    for (int o = 1; o < 64; o <<= 1) { const float t = __shfl_up(incl, o); if (lane >= o) incl += t; }
    const float excl = incl - (d0 + d1);
    acs0 = excl + d0; acs1 = excl + d0 + d1;
    total = __shfl(incl, 63);
}

__device__ __forceinline__ void ln_load(const float* xrow, int lane, f32x4 (&v)[4]) {
    const f32x4* xr = (const f32x4*)xrow + lane;
#pragma unroll
    for (int j = 0; j < 4; ++j) v[j] = xr[64 * j];
}
__device__ __forceinline__ void ln_apply(const float* g, const float* bta, int lane, f32x4 (&v)[4]) {
    float s = 0.f;
#pragma unroll
    for (int j = 0; j < 4; ++j) s += (v[j].x + v[j].y) + (v[j].z + v[j].w);
    const float mean = wave_sum(s) * (1.f / DM); float s2 = 0.f;
#pragma unroll
    for (int j = 0; j < 4; ++j) { v[j] = v[j] - mean; s2 += (v[j].x * v[j].x + v[j].y * v[j].y) + (v[j].z * v[j].z + v[j].w * v[j].w); }
    const float rstd = 1.f / sqrtf(wave_sum(s2) * (1.f / DM) + LN_EPS);
#pragma unroll
    for (int j = 0; j < 4; ++j) { const f32x4 gg = *((const f32x4*)g + lane + 64 * j), bb = *((const f32x4*)bta + lane + 64 * j); v[j] = v[j] * rstd * gg + bb; }
}

#define XB_TMO      128
#define XB_XCNT(j)  (256  + 64 * (j))
#define XB_XSUB(j)  (1280 + 64 * (j))
#define XB_XGEN(j)  (2304 + 64 * (j))
#define XB_TOP      3328
#define XB_TOPGEN   3392
#define XCD_BAR_WORDS 3456
#define XB_SPIN_CAP (1u << 18)

__device__ __forceinline__ unsigned xb_ld(unsigned* p)              { return __hip_atomic_load(p, __ATOMIC_RELAXED, __HIP_MEMORY_SCOPE_AGENT); }
__device__ __forceinline__ unsigned xb_add(unsigned* p, unsigned v) { return __hip_atomic_fetch_add(p, v, __ATOMIC_RELAXED, __HIP_MEMORY_SCOPE_AGENT); }
__device__ __forceinline__ unsigned xb_xcc_id() { return (unsigned)__builtin_amdgcn_s_getreg((3 << 11) | 20) & 0xFu; }
#define XB_SPIN(cond, bar) do { unsigned _sp = 0; while (cond) { __builtin_amdgcn_s_sleep(1); \
    if ((++_sp & 255u) == 0u) { if (xb_ld(&(bar)[XB_TMO])) break; if (_sp > XB_SPIN_CAP) { atomicAdd(&(bar)[XB_TMO], 1u); break; } } } } while (0)

struct XcdBarrier {
    unsigned* bar; unsigned x;
    volatile LAS unsigned* st;
};

__device__ __forceinline__ XcdBarrier xcd_barrier_post(unsigned* bar, volatile LAS unsigned* st) {
    XcdBarrier b; b.bar = bar; b.x = xb_xcc_id(); b.st = st;
    if (threadIdx.x == 0) (void)xb_add(&bar[XB_XCNT(b.x)], 1u);
    return b;
}
__device__ __forceinline__ void xcd_barrier_complete(unsigned* bar, unsigned x, unsigned& nloc, unsigned& nx) {
    const unsigned G = gridDim.x * gridDim.y * gridDim.z;
    unsigned sum, cnt, mine, sp = 0u;
    for (;;) {
        sum = 0u; cnt = 0u; mine = 0u;
#pragma unroll
        for (unsigned j = 0; j < 16; ++j) { const unsigned c = xb_ld(&bar[XB_XCNT(j)]); sum += c; cnt += (c > 0u) ? 1u : 0u; mine = (j == x) ? c : mine; }
        if (sum == G) break;
        __builtin_amdgcn_s_sleep(1);
        if ((++sp & 255u) == 0u) { if (xb_ld(&bar[XB_TMO])) break; if (sp > XB_SPIN_CAP) { atomicAdd(&bar[XB_TMO], 1u); break; } }
    }
    nloc = mine > 0u ? mine : 1u; nx = cnt > 0u ? cnt : 1u;
}

__device__ __forceinline__ void xcd_barrier(const XcdBarrier& b) {
    asm volatile("s_waitcnt vmcnt(0)" ::: "memory");
    __syncthreads();
    if (threadIdx.x == 0) {
        unsigned* bar = b.bar;
        __builtin_amdgcn_s_waitcnt(0);
        unsigned nloc = b.st[0], nx = b.st[1];
        if (nloc == 0u) { xcd_barrier_complete(bar, b.x, nloc, nx); b.st[0] = nloc; b.st[1] = nx; }
        const unsigned old = xb_add(&bar[XB_XSUB(b.x)], 1u);
        const unsigned gen = old / nloc;
        if (old + 1u == (gen + 1u) * nloc) {
            __builtin_amdgcn_fence(__ATOMIC_RELEASE, "agent");
            asm volatile("s_waitcnt vmcnt(0)" ::: "memory");
            const unsigned og = xb_add(&bar[XB_TOP], 1u);
            const unsigned tg = og / nx;
            if (og + 1u == (tg + 1u) * nx) xb_add(&bar[XB_TOPGEN], 1u);
            else XB_SPIN(xb_ld(&bar[XB_TOPGEN]) == tg, bar);
            __builtin_amdgcn_fence(__ATOMIC_ACQUIRE, "agent");
            xb_add(&bar[XB_XGEN(b.x)], 1u);
            asm volatile("s_waitcnt vmcnt(0)" ::: "memory");
        } else {
            XB_SPIN(xb_ld(&bar[XB_XGEN(b.x)]) == gen, bar);
            __builtin_amdgcn_fence(__ATOMIC_ACQUIRE, "agent");
            asm volatile("s_waitcnt vmcnt(0)" ::: "memory");
        }
    }
    __syncthreads();
}

#ifndef MK_DUPMASK
#define MK_DUPMASK 0
#endif
#ifndef MK_SYNCREP
#define MK_SYNCREP 1
#endif
__global__ void __launch_bounds__(NTHREADS, 2) mk_fwd(Args args) {
    extern __shared__ __attribute__((aligned(16))) unsigned char lds[];
    LAS unsigned char* const L = (LAS unsigned char*)lds;
    const int tid = threadIdx.x, lane = tid & 63, wave = __builtin_amdgcn_readfirstlane(tid >> 6);
    const int G = gridDim.x, bid = blockIdx.x;
    const int gw = bid * NWAVES + wave, NGW = G * NWAVES;
#define dout (A_->out)
#define x_prompt (A_->in[0])
#define x_sample (A_->in[1])
#define state_conv (A_->in[2])
#define state_ssm_conv (A_->in[3])
#define state_ssm (A_->in[4])
#define c_prompt (A_->in[5])
#define c_sample (A_->in[6])
#define w_ada (A_->in[7])
#define b_ada (A_->in[8])
#define w_in (A_->in[9])
#define conv_w (A_->in[10])
#define conv_norm_w (A_->in[11])
#define ssm_conv_w (A_->in[12])
#define ssm_conv_b (A_->in[13])
#define dt_bias (A_->in[14])
#define a_log (A_->in[15])
#define d_skip (A_->in[16])
#define ssm_norm_w (A_->in[17])
#define w_out (A_->in[18])
#define ln1_g (A_->in[19])
#define ln1_b (A_->in[20])
#define w_up (A_->in[21])
#define w_down (A_->in[22])
#define ln2_g (A_->in[23])
#define ln2_b (A_->in[24])
#define WadaT ((bf16_t*)(A_->ws + WS_WADA))
#define WinT ((bf16_t*)(A_->ws + WS_WIN))
#define WoutT ((bf16_t*)(A_->ws + WS_WOUT))
#define WupT ((bf16_t*)(A_->ws + WS_WUP))
#define WdownT ((bf16_t*)(A_->ws + WS_WDOWN))
#define cbf ((bf16_t*)(A_->ws + WS_CBF))
#define mod ((float*)(A_->ws + WS_MOD))
#define dtraw ((float*)(A_->ws + WS_DTRAW))
#define sxbc ((float*)(A_->ws + WS_SXBC))
#define cdec ((float*)(A_->ws + WS_CDEC))
#define ubf ((bf16_t*)(A_->ws + WS_S0))
#define xT ((bf16_t*)(A_->ws + WS_S0))
#define vbf ((bf16_t*)(A_->ws + WS_S0))
#define gbB ((bf16_t*)(A_->ws + WS_S1))
#define CS ((float*)(A_->ws + WS_S1))
#define pre1 ((float*)(A_->ws + WS_S1))
#define hid ((bf16_t*)(A_->ws + WS_S1))
#define hvB ((bf16_t*)(A_->ws + WS_S2))
#define xbcB ((bf16_t*)(A_->ws + WS_S3))
#define Sprev ((bf16_t*)(A_->ws + WS_S3))
#define zB ((bf16_t*)(A_->ws + WS_S4))
#define BC ((bf16_t*)(A_->ws + WS_S5))
#define BT ((bf16_t*)(A_->ws + WS_BT))
#define gcB ((bf16_t*)(A_->out + O_NSS))
#define ymix ((bf16_t*)(A_->out + O_Y))
#define Yf (A_->out + O_Y)
    const int lo = args.ph_lo, hi = args.ph_hi;
    volatile LAS unsigned* MISC = (volatile LAS unsigned*)(L + 147200);
    if (tid < 16) MISC[tid] = 0u;
    __syncthreads();
    XcdBarrier bar; bar.bar = (unsigned*)args.ws + 1024; bar.x = 0; bar.st = MISC;
    if (hi - lo > 1) bar = xcd_barrier_post((unsigned*)args.ws + 1024, MISC);
#define IN(k) (lo <= (k) && (k) < hi)
#define SEAM(k) do { if (IN(k) && IN((k) + 1)) { for (int sr_ = 0; sr_ < MK_SYNCREP; ++sr_) xcd_barrier(bar); } } while (0)

    if (IN(0)) for (int rep_ = 0; rep_ < (((MK_DUPMASK >> 0) & 1) ? 2 : 1); ++rep_) { CArgs A_ = AP();
        LAS float* scr = (LAS float*)(L + wave * 16384);
        constexpr int I_ADA = 16 * 192, I_IN = 16 * 176, I_OUT = 32 * 32, I_UP = 16 * 128, I_DOWN = 64 * 32;
        constexpr int NITEMS = I_ADA + I_IN + I_OUT + I_UP + I_DOWN;
        for (int it = gw; it < NITEMS; it += NGW) {
            int r = it;
            if (r < I_ADA) { transpose_item(w_ada, 6144, 192, 1024, WadaT, scr, r, lane); continue; } r -= I_ADA;
            if (r < I_IN) { transpose_item(w_in, NINW, 176, 1024, WinT, scr, r, lane); continue; } r -= I_IN;
            if (r < I_OUT) { transpose_item(w_out, 1024, 32, 2048, WoutT, scr, r, lane); continue; } r -= I_OUT;
            if (r < I_UP) { transpose_item(w_up, 4096, 128, 1024, WupT, scr, r, lane); continue; } r -= I_UP;
            transpose_item(w_down, 1024, 32, 4096, WdownT, scr, r, lane);
        }
        for (int r = gw; r < 144; r += NGW) {
            const float* src = r < 8 ? c_prompt + (size_t)r * DM : c_sample + (size_t)(r - 8) * DM;
#pragma unroll
            for (int j = 0; j < 4; ++j) { f32x4 v = {0.f, 0.f, 0.f, 0.f}; if (r < 136) v = *((const f32x4*)src + lane + 64 * j);
                u32x2 w; w.x = pk2(v.x, v.y); w.y = pk2(v.z, v.w); *((u32x2*)(cbf + (size_t)r * DM) + lane + 64 * j) = w; }
        }
    }
    SEAM(0);
    if (IN(1)) for (int rep_ = 0; rep_ < (((MK_DUPMASK >> 1) & 1) ? 2 : 1); ++rep_) { CArgs A_ = AP();
        EpiMod E{mod, b_ada};
        small_gemm<1>((LAS float*)L, cbf, DM, WadaT, DM, 9, 9 * 384, 1024, E, bid, G);
    }
    SEAM(1);
    if (IN(2)) for (int rep_ = 0; rep_ < (((MK_DUPMASK >> 2) & 1) ? 2 : 1); ++rep_) { CArgs A_ = AP();
        LAS float* w16 = (LAS float*)L;
        for (int i = tid; i < 4096; i += NTHREADS) { const int k = i >> 2, c4 = i & 3; *(LAS f32x4*)(w16 + k * 20 + c4 * 4) = *(const f32x4*)(w_in + (size_t)k * NINW + NINM + c4 * 4); }
        __syncthreads();
        for (int r = gw; r < NR; r += NGW) {
            const float* xrow = r < NP ? x_prompt + (size_t)r * DM : x_sample + (size_t)(r - NP) * DM;
            const float* mrow = mod + (size_t)(r < NP ? (r >> 11) : 8 + r - NP) * 6144;
            float acc[16];
#pragma unroll
            for (int c = 0; c < 16; ++c) acc[c] = 0.f;
#pragma unroll
            for (int j = 0; j < 4; ++j) {
                const f32x4 xv = *((const f32x4*)xrow + lane + 64 * j), sh = *((const f32x4*)mrow + lane + 64 * j), sc = *((const f32x4*)(mrow + 1024) + lane + 64 * j);
                const f32x4 u = xv * (sc + 1.0f) + sh;
                u32x2 w; w.x = pk2(u.x, u.y); w.y = pk2(u.z, u.w); *((u32x2*)(ubf + (size_t)r * DM) + lane + 64 * j) = w;
#pragma unroll
                for (int e = 0; e < 4; ++e) { const int k = 256 * j + 4 * lane + e; const LAS f32x4* wp = (const LAS f32x4*)(w16 + k * 20);
#pragma unroll
                    for (int c4 = 0; c4 < 4; ++c4) { const f32x4 wv = wp[c4];
#pragma unroll
                        for (int q = 0; q < 4; ++q) acc[c4 * 4 + q] += u[e] * wv[q]; } }
            }
#pragma unroll
            for (int c = 0; c < 16; ++c) acc[c] = wave_sum(acc[c]);
            if (lane == 0) {
#pragma unroll
                for (int c4 = 0; c4 < 4; ++c4) *(f32x4*)(dtraw + (size_t)r * 16 + c4 * 4) = (f32x4){acc[c4 * 4], acc[c4 * 4 + 1], acc[c4 * 4 + 2], acc[c4 * 4 + 3]};
            }
        }
        __syncthreads();
    }
    SEAM(2);
    if (IN(3)) for (int rep_ = 0; rep_ < (((MK_DUPMASK >> 3) & 1) ? 2 : 1); ++rep_) { CArgs A_ = AP();
        pg8::Gemm g{ubf, WinT, NP, NINM, DM}; pg8::StaticOrder S; S.init(NP, NINM, G, bid);
        pg8::EpiProj E{gbB, gcB, hvB, zB, xbcB};
        pg8::gemm_phase<pg8::EpiProj, pg8::StaticOrder, true, true>(L, g, S, E);
        __syncthreads();
        EpiProjS ES{gbB, gcB, hvB, zB, xbcB};
        small_gemm<1>((LAS float*)L, ubf + (size_t)NP * DM, DM, WinT, DM, 8, 8 * 352, 1024, ES, (bid + 128) % G, G);
    }
    SEAM(3);
    if (IN(4)) for (int rep_ = 0; rep_ < (((MK_DUPMASK >> 4) & 1) ? 2 : 1); ++rep_) { CArgs A_ = AP();
        for (int T = gw; T < 2048 + 128; T += NGW) {
            const bool smp = T >= 2048; const int row0 = smp ? NP + (T - 2048) : T * 8, n = smp ? 1 : 8;
            const int b = row0 >> 11, t0 = row0 & 2047, c0 = 16 * lane;
            float cw[3][16], nw[16], p1[16], p2[16];
#pragma unroll
            for (int k = 0; k < 3; ++k)
#pragma unroll
                for (int q = 0; q < 4; ++q) { const f32x4 v = *(const f32x4*)(conv_w + k * 1024 + c0 + 4 * q); cw[k][4 * q] = v.x; cw[k][4 * q + 1] = v.y; cw[k][4 * q + 2] = v.z; cw[k][4 * q + 3] = v.w; }
#pragma unroll
            for (int q = 0; q < 4; ++q) { const f32x4 v = *(const f32x4*)(conv_norm_w + c0 + 4 * q); nw[4 * q] = v.x; nw[4 * q + 1] = v.y; nw[4 * q + 2] = v.z; nw[4 * q + 3] = v.w; }
            if (smp) {
                const float* st = state_conv + (size_t)(T - 2048) * 2048 + c0;
#pragma unroll
                for (int q = 0; q < 4; ++q) { const f32x4 a = *(const f32x4*)(st + 4 * q), bb = *(const f32x4*)(st + 1024 + 4 * q);
                    p2[4 * q] = a.x; p2[4 * q + 1] = a.y; p2[4 * q + 2] = a.z; p2[4 * q + 3] = a.w; p1[4 * q] = bb.x; p1[4 * q + 1] = bb.y; p1[4 * q + 2] = bb.z; p1[4 * q + 3] = bb.w; }
            } else if (t0 == 0) {
#pragma unroll
                for (int e = 0; e < 16; ++e) { p1[e] = 0.f; p2[e] = 0.f; }
            } else {
#pragma unroll
                for (int hh = 0; hh < 2; ++hh) {
                    float a[16], bb[16];
                    const size_t o2 = (size_t)(row0 - 2) * 1024 + c0 + 8 * hh, o1 = (size_t)(row0 - 1) * 1024 + c0 + 8 * hh;
                    unpack8(*(const u32x4*)(gcB + o2), a); unpack8(*(const u32x4*)(hvB + o2), a + 8);
                    unpack8(*(const u32x4*)(gcB + o1), bb); unpack8(*(const u32x4*)(hvB + o1), bb + 8);
#pragma unroll
                    for (int e = 0; e < 8; ++e) { p2[8 * hh + e] = a[e] * a[8 + e]; p1[8 * hh + e] = bb[e] * bb[8 + e]; }
                }
            }
#pragma unroll 2
            for (int i = 0; i < n; ++i) {
                const int row = row0 + i; float gv[16], cv[16], hv[16], ch[16], y[16];
                const size_t o = (size_t)row * 1024 + c0;
                unpack8(*(const u32x4*)(gbB + o), gv); unpack8(*(const u32x4*)(gbB + o + 8), gv + 8);
                unpack8(*(const u32x4*)(gcB + o), cv); unpack8(*(const u32x4*)(gcB + o + 8), cv + 8);
                unpack8(*(const u32x4*)(hvB + o), hv); unpack8(*(const u32x4*)(hvB + o + 8), hv + 8);
                float ss = 0.f;
#pragma unroll
                for (int e = 0; e < 16; ++e) { ch[e] = cv[e] * hv[e]; const float c3 = cw[0][e] * p2[e] + cw[1][e] * p1[e] + cw[2][e] * ch[e]; y[e] = gv[e] * c3; ss += y[e] * y[e]; }
                ss += __shfl_xor(ss, 1); ss += __shfl_xor(ss, 2);
                const float rstd = 1.0f / sqrtf(ss * (1.f / 64.f) + RMS_EPS);
                u32x4 w0, w1;
                w0.x = pk2(y[0] * rstd * nw[0], y[1] * rstd * nw[1]); w0.y = pk2(y[2] * rstd * nw[2], y[3] * rstd * nw[3]); w0.z = pk2(y[4] * rstd * nw[4], y[5] * rstd * nw[5]); w0.w = pk2(y[6] * rstd * nw[6], y[7] * rstd * nw[7]);
                w1.x = pk2(y[8] * rstd * nw[8], y[9] * rstd * nw[9]); w1.y = pk2(y[10] * rstd * nw[10], y[11] * rstd * nw[11]); w1.z = pk2(y[12] * rstd * nw[12], y[13] * rstd * nw[13]); w1.w = pk2(y[14] * rstd * nw[14], y[15] * rstd * nw[15]);
                *(u32x4*)(ymix + (size_t)row * MIX + c0) = w0; *(u32x4*)(ymix + (size_t)row * MIX + c0 + 8) = w1;
                if (smp) {
                    float* o0 = dout + O_NCS + (size_t)(T - 2048) * 2048 + c0;
#pragma unroll
                    for (int q = 0; q < 4; ++q) { *(f32x4*)(o0 + 4 * q) = (f32x4){p1[4 * q], p1[4 * q + 1], p1[4 * q + 2], p1[4 * q + 3]}; *(f32x4*)(o0 + 1024 + 4 * q) = (f32x4){ch[4 * q], ch[4 * q + 1], ch[4 * q + 2], ch[4 * q + 3]}; }
                } else if (t0 + i >= 2046) {
                    float* o0 = dout + O_NCP + (size_t)(b * 2 + (t0 + i - 2046)) * 1024 + c0;
#pragma unroll
                    for (int q = 0; q < 4; ++q) *(f32x4*)(o0 + 4 * q) = (f32x4){ch[4 * q], ch[4 * q + 1], ch[4 * q + 2], ch[4 * q + 3]};
                }
#pragma unroll
                for (int e = 0; e < 16; ++e) { p2[e] = p1[e]; p1[e] = ch[e]; }
            }
        }
        for (int T = gw; T < 3 * (2048 + 128); T += NGW) {
            const int j = T % 3, strip = T / 3; const bool smp = strip >= 2048;
            const int row0 = smp ? NP + (strip - 2048) : strip * 8;
            const int b = row0 >> 11, t0 = row0 & 2047, c0 = j * 512 + 8 * lane;
            float w[4][8], bias[8], q1[8], q2[8], q3[8];
#pragma unroll
            for (int k = 0; k < 4; ++k) { const f32x4 a = *(const f32x4*)(ssm_conv_w + k * XBC + c0), bb = *(const f32x4*)(ssm_conv_w + k * XBC + c0 + 4);
                w[k][0] = a.x; w[k][1] = a.y; w[k][2] = a.z; w[k][3] = a.w; w[k][4] = bb.x; w[k][5] = bb.y; w[k][6] = bb.z; w[k][7] = bb.w; }
            { const f32x4 a = *(const f32x4*)(ssm_conv_b + c0), bb = *(const f32x4*)(ssm_conv_b + c0 + 4);
              bias[0] = a.x; bias[1] = a.y; bias[2] = a.z; bias[3] = a.w; bias[4] = bb.x; bias[5] = bb.y; bias[6] = bb.z; bias[7] = bb.w; }
            if (smp) {
                const int sb = strip - 2048; const float* st = state_ssm_conv + (size_t)sb * 3 * XBC + c0;
#pragma unroll
                for (int e = 0; e < 8; ++e) { q3[e] = st[e]; q2[e] = st[XBC + e]; q1[e] = st[2 * XBC + e]; }
                float cur[8]; unpack8(*(const u32x4*)(xbcB + (size_t)row0 * XBC + c0), cur);
                float val[8];
#pragma unroll
                for (int e = 0; e < 8; ++e) val[e] = siluf(w[0][e] * q3[e] + w[1][e] * q2[e] + w[2][e] * q1[e] + w[3][e] * cur[e] + bias[e]);
                *(f32x4*)(sxbc + (size_t)sb * XBC + c0) = (f32x4){val[0], val[1], val[2], val[3]}; *(f32x4*)(sxbc + (size_t)sb * XBC + c0 + 4) = (f32x4){val[4], val[5], val[6], val[7]};
                float* o0 = dout + O_NSCS + (size_t)sb * 3 * XBC + c0;
                *(f32x4*)(o0) = (f32x4){q2[0], q2[1], q2[2], q2[3]}; *(f32x4*)(o0 + 4) = (f32x4){q2[4], q2[5], q2[6], q2[7]};
                *(f32x4*)(o0 + XBC) = (f32x4){q1[0], q1[1], q1[2], q1[3]}; *(f32x4*)(o0 + XBC + 4) = (f32x4){q1[4], q1[5], q1[6], q1[7]};
                *(f32x4*)(o0 + 2 * XBC) = (f32x4){cur[0], cur[1], cur[2], cur[3]}; *(f32x4*)(o0 + 2 * XBC + 4) = (f32x4){cur[4], cur[5], cur[6], cur[7]};
            } else {
                if (t0 == 0) {
#pragma unroll
                    for (int e = 0; e < 8; ++e) { q1[e] = 0.f; q2[e] = 0.f; q3[e] = 0.f; }
                } else {
                    unpack8(*(const u32x4*)(xbcB + (size_t)(row0 - 3) * XBC + c0), q3); unpack8(*(const u32x4*)(xbcB + (size_t)(row0 - 2) * XBC + c0), q2); unpack8(*(const u32x4*)(xbcB + (size_t)(row0 - 1) * XBC + c0), q1);
                }
                unsigned ov[8][4];
                float prev[8];
#pragma unroll
                for (int i = 0; i < 8; ++i) {
                    const int row = row0 + i; float cur[8], val[8];
                    unpack8(*(const u32x4*)(xbcB + (size_t)row * XBC + c0), cur);
#pragma unroll
                    for (int e = 0; e < 8; ++e) val[e] = siluf(w[0][e] * q3[e] + w[1][e] * q2[e] + w[2][e] * q1[e] + w[3][e] * cur[e] + bias[e]);
                    if (j == 2) { u32x4 o; o.x = pk2(val[0], val[1]); o.y = pk2(val[2], val[3]); o.z = pk2(val[4], val[5]); o.w = pk2(val[6], val[7]); *(u32x4*)(BC + (size_t)row * 512 + 8 * lane) = o; }
                    if (i & 1) {
#pragma unroll
                        for (int e = 0; e < 8; ++e) ov[e][i >> 1] = pk2(prev[e], val[e]);
                    } else {
#pragma unroll
                        for (int e = 0; e < 8; ++e) prev[e] = val[e];
                    }
                    if (t0 + i >= 2045) { float* o0 = dout + O_NSCP + (size_t)(b * 3 + (t0 + i - 2045)) * XBC + c0;
                        *(f32x4*)(o0) = (f32x4){cur[0], cur[1], cur[2], cur[3]}; *(f32x4*)(o0 + 4) = (f32x4){cur[4], cur[5], cur[6], cur[7]}; }
#pragma unroll
                    for (int e = 0; e < 8; ++e) { q3[e] = q2[e]; q2[e] = q1[e]; q1[e] = cur[e]; }
                }
                const int chunk = t0 >> 7, s0 = t0 & 127;
                if (j < 2) {
#pragma unroll
                    for (int e = 0; e < 8; ++e) *(u32x4*)(xT + ((size_t)((b * 16 + chunk) * 1024 + c0 + e)) * 128 + s0) = (u32x4){ov[e][0], ov[e][1], ov[e][2], ov[e][3]};
                } else if (lane < 32) {
#pragma unroll
                    for (int e = 0; e < 8; ++e) *(u32x4*)(BT + ((size_t)((b * 16 + chunk) * 256 + 8 * lane + e)) * 128 + s0) = (u32x4){ov[e][0], ov[e][1], ov[e][2], ov[e][3]};
                }
            }
        }
    }
    SEAM(4);
    if (IN(5)) for (int rep_ = 0; rep_ < (((MK_DUPMASK >> 5) & 1) ? 2 : 1); ++rep_) { CArgs A_ = AP();
        LAS float* wl = (LAS float*)(L + wave * 512);
        const int r16 = lane & 15, quad = lane >> 4;
        for (int item = gw; item < 2048; item += NGW) {
            const int h = item & 15, bc = item >> 4, g = h >> 3, rowbase = bc * 128;
            float dt0, dt1, a0, a1, tot; const float aa = -__expf(a_log[h]);
            dt_scan(dtraw, rowbase, h, dt_bias[h], aa, lane, dt0, dt1, a0, a1, tot);
            wl[2 * lane] = dt0 * __expf(tot - a0); wl[2 * lane + 1] = dt1 * __expf(tot - a1);
            if (lane == 0) cdec[item] = __expf(tot);
            LDS_FENCE();
            const bf16_t* xtp = xT + ((size_t)(bc * 1024 + h * 64 + r16)) * 128 + quad * 8;
            bf16x8 xs[4][4];
#pragma unroll
            for (int kk = 0; kk < 4; ++kk) {
                const f32x4 wa = *(const LAS f32x4*)(wl + 32 * kk + quad * 8), wb = *(const LAS f32x4*)(wl + 32 * kk + quad * 8 + 4);
#pragma unroll
                for (int pt = 0; pt < 4; ++pt) {
                    const u32x4 raw = *(const u32x4*)(xtp + (size_t)pt * 16 * 128 + 32 * kk);
                    u32x4 sc; sc.x = pk2(bflo(raw.x) * wa.x, bfhi(raw.x) * wa.y); sc.y = pk2(bflo(raw.y) * wa.z, bfhi(raw.y) * wa.w);
                    sc.z = pk2(bflo(raw.z) * wb.x, bfhi(raw.z) * wb.y); sc.w = pk2(bflo(raw.w) * wb.z, bfhi(raw.w) * wb.w);
                    xs[kk][pt] = __builtin_bit_cast(bf16x8, sc);
                }
            }
            const bf16_t* btp = BT + ((size_t)(bc * 256 + g * 128 + r16)) * 128 + quad * 8;
#pragma unroll
            for (int nt = 0; nt < 8; ++nt) {
                f32x4 acc[4];
#pragma unroll
                for (int pt = 0; pt < 4; ++pt) acc[pt] = (f32x4){0.f, 0.f, 0.f, 0.f};
#pragma unroll
                for (int kk = 0; kk < 4; ++kk) { const bf16x8 bfr = *(const bf16x8*)(btp + (size_t)nt * 16 * 128 + 32 * kk);
#pragma unroll
                    for (int pt = 0; pt < 4; ++pt) acc[pt] = __builtin_amdgcn_mfma_f32_16x16x32_bf16(bfr, xs[kk][pt], acc[pt], 0, 0, 0); }
#pragma unroll
                for (int pt = 0; pt < 4; ++pt) *(f32x4*)(CS + (size_t)item * 8192 + (pt * 16 + r16) * 128 + 16 * nt + quad * 4) = acc[pt];
            }
            LDS_FENCE();
        }
    }
    SEAM(5);
    if (IN(6)) for (int rep_ = 0; rep_ < (((MK_DUPMASK >> 6) & 1) ? 2 : 1); ++rep_) { CArgs A_ = AP();
        for (int e = bid * NTHREADS + tid; e < 262144; e += G * NTHREADS) {
            const int n4 = e & 31, p = (e >> 5) & 63, h = (e >> 11) & 15, b = e >> 15;
            f32x4 cs[16]; float dc[16];
#pragma unroll
            for (int c = 0; c < 16; ++c) { cs[c] = *(const f32x4*)(CS + ((size_t)((b * 16 + c) * 16 + h)) * 8192 + p * 128 + n4 * 4); dc[c] = cdec[(b * 16 + c) * 16 + h]; }
            f32x4 S = {0.f, 0.f, 0.f, 0.f};
#pragma unroll
            for (int c = 0; c < 16; ++c) {
                u32x2 w; w.x = pk2(S.x, S.y); w.y = pk2(S.z, S.w);
                *(u32x2*)(Sprev + ((size_t)((b * 16 + c) * 16 + h)) * 8192 + p * 128 + n4 * 4) = w;
                S = S * dc[c] + cs[c];
            }
            *(f32x4*)(dout + O_NSP + ((size_t)((b * 16 + h) * 64 + p)) * 128 + n4 * 4) = S;
        }
    }
    SEAM(6);
    if (IN(7)) for (int rep_ = 0; rep_ < (((MK_DUPMASK >> 7) & 1) ? 2 : 1); ++rep_) { CArgs A_ = AP();
        LAS unsigned char* ysh = L + wave * (16 * 1032);
        LAS float* ldt = (LAS float*)(L + 132096); LAS float* lacs = (LAS float*)(L + 136192); LAS float* red = (LAS float*)(L + 140288);
        const int r16 = lane & 15, quad = lane >> 4;
        for (int item = bid; item < 256; item += G) {
            const int g = item & 1, bc = item >> 1, rowbase = bc * 128;
            { const int h = g * 8 + wave; float dt0, dt1, a0, a1, tot; const float aa = -__expf(a_log[h]);
              dt_scan(dtraw, rowbase, h, dt_bias[h], aa, lane, dt0, dt1, a0, a1, tot);
              ldt[wave * 128 + 2 * lane] = dt0; ldt[wave * 128 + 2 * lane + 1] = dt1; lacs[wave * 128 + 2 * lane] = a0; lacs[wave * 128 + 2 * lane + 1] = a1; }
            __syncthreads();
            const bf16_t* BCp = BC + (size_t)rowbase * 512;
            const int srow = 16 * wave + r16;
            bf16x8 cfr[4];
#pragma unroll
            for (int kk = 0; kk < 4; ++kk) cfr[kk] = *(const bf16x8*)(BCp + (size_t)srow * 512 + 256 + g * 128 + 32 * kk + quad * 8);
            f32x4 cbt[8];
#pragma unroll
            for (int tt = 0; tt < 8; ++tt) { cbt[tt] = (f32x4){0.f, 0.f, 0.f, 0.f};
                if (tt <= wave) {
#pragma unroll
                    for (int kk = 0; kk < 4; ++kk) { const bf16x8 bfr = *(const bf16x8*)(BCp + (size_t)(16 * tt + r16) * 512 + g * 128 + 32 * kk + quad * 8);
                        cbt[tt] = __builtin_amdgcn_mfma_f32_16x16x32_bf16(bfr, cfr[kk], cbt[tt], 0, 0, 0); } } }
            float ss = 0.f;
            for (int hh = 0; hh < 8; ++hh) {
                const int h = g * 8 + hh; const float acs_s = lacs[hh * 128 + srow], dsk = d_skip[h];
                bf16x8 gfr[4];
#pragma unroll
                for (int kk = 0; kk < 4; ++kk) {
                    unsigned pk[4];
#pragma unroll
                    for (int half = 0; half < 2; ++half) { const int tt = 2 * kk + half;
                        const f32x4 at = *(const LAS f32x4*)(lacs + hh * 128 + 16 * tt + quad * 4), dtt = *(const LAS f32x4*)(ldt + hh * 128 + 16 * tt + quad * 4);
                        float v[4];
#pragma unroll
                        for (int r = 0; r < 4; ++r) { const int t = 16 * tt + quad * 4 + r; float x = 0.f;
                            if (t <= srow) x = cbt[tt][r] * __expf(acs_s - at[r]) * dtt[r];
                            if (t == srow) x += dsk;
                            v[r] = x; }
                        pk[2 * half] = pk2(v[0], v[1]); pk[2 * half + 1] = pk2(v[2], v[3]); }
                    gfr[kk] = __builtin_bit_cast(bf16x8, (u32x4){pk[0], pk[1], pk[2], pk[3]});
                }
                f32x4 yd[4], yo[4];
#pragma unroll
                for (int pt = 0; pt < 4; ++pt) { yd[pt] = (f32x4){0.f, 0.f, 0.f, 0.f}; yo[pt] = (f32x4){0.f, 0.f, 0.f, 0.f}; }
                const bf16_t* xtp = xT + ((size_t)(bc * 1024 + h * 64 + r16)) * 128 + quad * 4;
                const bf16_t* spp = Sprev + ((size_t)(bc * 16 + h)) * 8192 + (size_t)r16 * 128 + quad * 8;
#pragma unroll
                for (int kk = 0; kk < 4; ++kk) {
                    if (2 * kk <= wave) {
#pragma unroll
                        for (int pt = 0; pt < 4; ++pt) { const u32x2 lo2 = *(const u32x2*)(xtp + (size_t)pt * 2048 + 32 * kk), hi2 = *(const u32x2*)(xtp + (size_t)pt * 2048 + 32 * kk + 16);
                            yd[pt] = __builtin_amdgcn_mfma_f32_16x16x32_bf16(__builtin_bit_cast(bf16x8, (u32x4){lo2.x, lo2.y, hi2.x, hi2.y}), gfr[kk], yd[pt], 0, 0, 0); }
                    }
#pragma unroll
                    for (int pt = 0; pt < 4; ++pt) { const bf16x8 sa = *(const bf16x8*)(spp + (size_t)pt * 2048 + 32 * kk);
                        yo[pt] = __builtin_amdgcn_mfma_f32_16x16x32_bf16(sa, cfr[kk], yo[pt], 0, 0, 0); }
                }
                const float es = __expf(acs_s);
#pragma unroll
                for (int pt = 0; pt < 4; ++pt) {
                    const u32x2 zr = *(const u32x2*)(zB + (size_t)(rowbase + srow) * 1024 + h * 64 + pt * 16 + quad * 4);
                    const float z0 = bflo(zr.x), z1 = bfhi(zr.x), z2 = bflo(zr.y), z3 = bfhi(zr.y);
                    const float y0 = (yd[pt][0] + es * yo[pt][0]) * siluf(z0), y1 = (yd[pt][1] + es * yo[pt][1]) * siluf(z1);
                    const float y2 = (yd[pt][2] + es * yo[pt][2]) * siluf(z2), y3 = (yd[pt][3] + es * yo[pt][3]) * siluf(z3);
                    ss += (y0 * y0 + y1 * y1) + (y2 * y2 + y3 * y3);
                    *(LAS u32x2*)(ysh + r16 * 1032 + (hh * 64 + pt * 16 + quad * 4) * 2) = (u32x2){pk2(y0, y1), pk2(y2, y3)};
                }
            }
            ss += __shfl_xor(ss, 16); ss += __shfl_xor(ss, 32);
            const float rstd = 1.0f / sqrtf(ss * (1.f / 512.f) + RMS_EPS);
            LDS_FENCE();
#pragma unroll 4
            for (int q = 0; q < 32; ++q) {
                const u32x2 yr = *(const LAS u32x2*)(ysh + r16 * 1032 + (q * 16 + quad * 4) * 2);
                const f32x4 nwv = *(const f32x4*)(ssm_norm_w + g * 512 + q * 16 + quad * 4);
                u32x2 o; o.x = pk2(bflo(yr.x) * rstd * nwv.x, bfhi(yr.x) * rstd * nwv.y); o.y = pk2(bflo(yr.y) * rstd * nwv.z, bfhi(yr.y) * rstd * nwv.w);
                *(u32x2*)(ymix + (size_t)(rowbase + srow) * MIX + 1024 + g * 512 + q * 16 + quad * 4) = o;
            }
            __syncthreads();
        }
        for (int item = bid; item < 256; item += G) {
            const int g = item & 1, sb = item >> 1, h = g * 8 + wave;
            const float dt = softplusf(dtraw[(size_t)(NP + sb) * 16 + h] + dt_bias[h]); const float dA = __expf(dt * -__expf(a_log[h]));
            const float* sx = sxbc + (size_t)sb * XBC;
            const int n4 = lane & 31, ph = lane >> 5;
            const f32x4 Bv = *(const f32x4*)(sx + 1024 + g * 128 + 4 * n4), Cv = *(const f32x4*)(sx + 1280 + g * 128 + 4 * n4);
            const float* sp = state_ssm + ((size_t)(sb * 16 + h) * 64) * 128 + 4 * n4; float* op = dout + O_NSS + ((size_t)(sb * 16 + h) * 64) * 128 + 4 * n4;
            float ymine = 0.f;
#pragma unroll 8
            for (int i = 0; i < 32; ++i) {
                const int p = i + 32 * ph; const float xv = sx[h * 64 + p] * dt;
                const f32x4 S = *(const f32x4*)(sp + (size_t)p * 128); const f32x4 Sn = S * dA + Bv * xv;
                *(f32x4*)(op + (size_t)p * 128) = Sn;
                float part = (Cv.x * Sn.x + Cv.y * Sn.y) + (Cv.z * Sn.z + Cv.w * Sn.w);
                part += __shfl_xor(part, 1); part += __shfl_xor(part, 2); part += __shfl_xor(part, 4); part += __shfl_xor(part, 8); part += __shfl_xor(part, 16);
                if ((lane & 31) == i) ymine = part;
            }
            const float xme = sx[h * 64 + lane];
            const float zz = bflo((unsigned)zB[(size_t)(NP + sb) * 1024 + h * 64 + lane]);
            const float y = (ymine + d_skip[h] * xme) * siluf(zz);
            const float s2 = wave_sum(y * y);
            if (lane == 0) red[wave] = s2;
            __syncthreads();
            float tot = 0.f;
#pragma unroll
            for (int q = 0; q < 8; ++q) tot += red[q];
            const float rstd = 1.0f / sqrtf(tot * (1.f / 512.f) + RMS_EPS);
            ymix[(size_t)(NP + sb) * MIX + 1024 + g * 512 + wave * 64 + lane] = (bf16_t)f2bf(y * rstd * ssm_norm_w[g * 512 + wave * 64 + lane]);
            __syncthreads();
        }
    }
    SEAM(7);
    if (IN(8)) for (int rep_ = 0; rep_ < (((MK_DUPMASK >> 8) & 1) ? 2 : 1); ++rep_) { CArgs A_ = AP();
        pg8::Gemm g{ymix, WoutT, NP, DM, MIX}; pg8::StaticOrder S; S.init(NP, DM, G, bid);
        pg8::EpiRes E{x_prompt, pre1, mod + 2048, ALPHA};
        pg8::gemm_phase<pg8::EpiRes, pg8::StaticOrder, true, true>(L, g, S, E);
        __syncthreads();
        EpiResS ES{x_sample, pre1 + (size_t)NP * DM, mod + 8 * 6144 + 2048};
        small_gemm<4>((LAS float*)L, ymix + (size_t)NP * MIX, MIX, WoutT, MIX, 8, 8 * 64, MIX, ES, bid, G);
    }
    SEAM(8);
    if (IN(9)) for (int rep_ = 0; rep_ < (((MK_DUPMASK >> 9) & 1) ? 2 : 1); ++rep_) { CArgs A_ = AP();
        for (int r0 = gw * 4; r0 < NR; r0 += NGW * 4) {
            f32x4 v[4][4];
#pragma unroll
            for (int q = 0; q < 4; ++q) ln_load(pre1 + (size_t)(r0 + q) * DM, lane, v[q]);
#pragma unroll
            for (int q = 0; q < 4; ++q) { const int r = r0 + q; ln_apply(ln1_g, ln1_b, lane, v[q]);
                const float* mrow = mod + (size_t)(r < NP ? (r >> 11) : 8 + r - NP) * 6144;
#pragma unroll
                for (int j = 0; j < 4; ++j) { *((f32x4*)(Yf + (size_t)r * DM) + lane + 64 * j) = v[q][j];
                    const f32x4 sh = *((const f32x4*)(mrow + 3072) + lane + 64 * j), sc = *((const f32x4*)(mrow + 4096) + lane + 64 * j);
                    const f32x4 u = v[q][j] * (sc + 1.0f) + sh; u32x2 w; w.x = pk2(u.x, u.y); w.y = pk2(u.z, u.w); *((u32x2*)(vbf + (size_t)r * DM) + lane + 64 * j) = w; } }
        }
    }
    SEAM(9);
    if (IN(10)) for (int rep_ = 0; rep_ < (((MK_DUPMASK >> 10) & 1) ? 2 : 1); ++rep_) { CArgs A_ = AP();
        pg8::Gemm g{vbf, WupT, NP, DFF, DM}; pg8::StaticOrder S; S.init(NP, DFF, G, bid);
        pg8::EpiHid E{hid, DFF};
        pg8::gemm_phase<pg8::EpiHid, pg8::StaticOrder, true, true>(L, g, S, E);
        __syncthreads();
        EpiHidS ES{hid};
        small_gemm<1>((LAS float*)L, vbf + (size_t)NP * DM, DM, WupT, DM, 8, 8 * 256, 1024, ES, bid, G);
    }
    SEAM(10);
    if (IN(11)) for (int rep_ = 0; rep_ < (((MK_DUPMASK >> 11) & 1) ? 2 : 1); ++rep_) { CArgs A_ = AP();
        pg8::Gemm g{hid, WdownT, NP, DM, DFF}; pg8::StaticOrder S; S.init(NP, DM, G, bid);
        pg8::EpiRes E{Yf, Yf, mod + 5120, ALPHA};
        pg8::gemm_phase<pg8::EpiRes, pg8::StaticOrder, true, true>(L, g, S, E);
        __syncthreads();
        EpiResS ES{Yf + (size_t)NP * DM, Yf + (size_t)NP * DM, mod + 8 * 6144 + 5120};
        small_gemm<4>((LAS float*)L, hid + (size_t)NP * DFF, DFF, WdownT, DFF, 8, 8 * 64, DFF, ES, bid, G);
    }
    SEAM(11);
    if (IN(12)) for (int rep_ = 0; rep_ < (((MK_DUPMASK >> 12) & 1) ? 2 : 1); ++rep_) { CArgs A_ = AP();
        for (int r0 = gw * 4; r0 < NR; r0 += NGW * 4) {
            f32x4 v[4][4];
#pragma unroll
            for (int q = 0; q < 4; ++q) ln_load(Yf + (size_t)(r0 + q) * DM, lane, v[q]);
#pragma unroll
            for (int q = 0; q < 4; ++q) { ln_apply(ln2_g, ln2_b, lane, v[q]);
#pragma unroll
                for (int j = 0; j < 4; ++j) *((f32x4*)(Yf + (size_t)(r0 + q) * DM) + lane + 64 * j) = v[q][j]; }
        }
    }
#undef IN
#undef SEAM
}
#undef dout
#undef x_prompt
#undef x_sample
#undef state_conv
#undef state_ssm_conv
#undef state_ssm
#undef c_prompt
#undef c_sample
#undef w_ada
#undef b_ada
#undef w_in
#undef conv_w
#undef conv_norm_w
#undef ssm_conv_w
#undef ssm_conv_b
#undef dt_bias
#undef a_log
#undef d_skip
#undef ssm_norm_w
#undef w_out
#undef ln1_g
#undef ln1_b
#undef w_up
#undef w_down
#undef ln2_g
#undef ln2_b
#undef WadaT
#undef WinT
#undef WoutT
#undef WupT
#undef WdownT
#undef cbf
#undef mod
#undef dtraw
#undef sxbc
#undef cdec
#undef ubf
#undef xT
#undef vbf
#undef gbB
#undef CS
#undef pre1
#undef hid
#undef hvB
#undef xbcB
#undef Sprev
#undef zB
#undef BC
#undef BT
#undef gcB
#undef ymix
#undef Yf

#ifndef MK_N_LAUNCHES
#define MK_N_LAUNCHES 1
#endif
constexpr int N_PHASES = 13;
extern "C" void kernel_launch(void* const* d_in, const int* in_sizes, int n_in, void* d_out, int out_size, void* d_ws, size_t ws_size, hipStream_t stream) {
    static int grid = 0;
    if (grid == 0) {
        int dev = 0, cus = 0, per_cu = 0;
        hipGetDevice(&dev);
        hipDeviceGetAttribute(&cus, hipDeviceAttributeMultiprocessorCount, dev);
        if (hipFuncSetAttribute((const void*)mk_fwd, hipFuncAttributeMaxDynamicSharedMemorySize, LDS_BYTES) != hipSuccess) { fprintf(stderr, "kernel_launch: hipFuncSetAttribute failed\n"); }
        if (hipOccupancyMaxActiveBlocksPerMultiprocessor(&per_cu, (const void*)mk_fwd, NTHREADS, LDS_BYTES) != hipSuccess || per_cu < 1) { fprintf(stderr, "kernel_launch: occupancy query says %d\n", per_cu); per_cu = 1; }
        (void)hipGetLastError();
        grid = cus * (per_cu > 1 ? 1 : per_cu);
        if (grid > 256) grid = 256;
    }
    Args a{};
    for (int i = 0; i < 25; ++i) a.in[i] = (const float*)d_in[i];
    a.out = (float*)d_out; a.ws = (unsigned char*)d_ws;
    if (hipMemsetAsync(d_ws, 0, 65536, stream) != hipSuccess) fprintf(stderr, "kernel_launch: memset of the control words failed\n");
    if (MK_N_LAUNCHES == 1) {
        a.ph_lo = 0; a.ph_hi = N_PHASES;
        void* kargs[] = {&a};
        hipError_t e = hipLaunchCooperativeKernel((const void*)mk_fwd, dim3(grid), dim3(NTHREADS), kargs, LDS_BYTES, stream);
        if (e != hipSuccess) fprintf(stderr, "cooperative launch failed: %s (grid %d)\n", hipGetErrorString(e), grid);
    } else {
        for (int p = 0; p < N_PHASES; ++p) { a.ph_lo = p; a.ph_hi = p + 1; hipLaunchKernelGGL(mk_fwd, dim3(grid), dim3(NTHREADS), LDS_BYTES, stream, a); }
    }
}
```
